# Optimizing an MI355X kernel written in HIP

```python
import math
import jax, jax.numpy as jnp
from jax import lax
import numpy as np

D_MODEL = 2048
BATCH = 4
SEQ = 4096
DEPTH = 2

GRID_W = 64
CTX_LEN = 256
D_MIX = D_MODEL
D_CONV = D_MIX // 4
D_ATTN = D_MIX // 2
D_POOL = D_MIX // 4
N_HEADS = 8
V_DIM = D_ATTN // N_HEADS
QK_DIM = V_DIM // 2
ATTN_SCALE = QK_DIM ** -0.5
Q_BLOCK = 128
CONV_W = 3
POOL_WINDOWS = (2, 4, 8, 16)
N_POOL_GROUPS = 4
POOL_GROUP = D_POOL // N_POOL_GROUPS
ROPE_THETA = 10000.0
LN_EPS = 1e-5
RMS_EPS = 1e-5
DEEPNORM_ALPHA = (2 * DEPTH) ** 0.25
DEEPNORM_BETA = (8 * DEPTH) ** -0.25
SPLIT_SIZES = (D_CONV, D_CONV, D_CONV, D_CONV, D_ATTN, D_ATTN, D_ATTN, D_ATTN, D_POOL, D_POOL)
SPLIT_POINTS = tuple(int(s) for s in np.cumsum(SPLIT_SIZES)[:-1])
D_IN = sum(SPLIT_SIZES)
ATT_K_OFF = 4 * D_CONV + D_ATTN
ATT_V_END = 4 * D_CONV + 3 * D_ATTN

kernel_name = 'hybrid_parallel_heads_dit_block'


def _layernorm(x, g, b):
    xf = x.astype(jnp.float32)
    mu = jnp.mean(xf, axis=-1, keepdims=True)
    var = jnp.mean(jnp.square(xf - mu), axis=-1, keepdims=True)
    return ((xf - mu) * lax.rsqrt(var + LN_EPS) * g + b).astype(x.dtype)


def _qk_heads(t):
    return t.reshape(t.shape[0], t.shape[1], N_HEADS, 2, QK_DIM)


def _v_heads(t):
    return t.reshape(t.shape[0], t.shape[1], N_HEADS, V_DIM)


def _rope_axial(x, rows, cols):
    half = QK_DIM // 2
    n = half // 2
    inv = ROPE_THETA ** (-jnp.arange(n, dtype=jnp.float32) / n)

    def rot(v, pos):
        ang = pos.astype(jnp.float32)[:, None] * inv
        cos = jnp.cos(ang)[None, :, None, None, :]
        sin = jnp.sin(ang)[None, :, None, None, :]
        v1, v2 = v[..., :n], v[..., n:]
        return jnp.concatenate([v1 * cos - v2 * sin, v1 * sin + v2 * cos], axis=-1)

    xf = x.astype(jnp.float32)
    return jnp.concatenate([rot(xf[..., :half], rows), rot(xf[..., half:], cols)], axis=-1).astype(x.dtype)


def _diff_attn(qb, k_all, v_all, lam):
    s = jnp.einsum('bqhid,bkhid->bhiqk', qb.astype(jnp.float32) * ATTN_SCALE, k_all.astype(jnp.float32))
    p = jax.nn.softmax(s, axis=-1)
    a = p[:, :, 0] - lam * p[:, :, 1]
    return jnp.einsum('bhqk,bkhe->bqhe', a.astype(v_all.dtype), v_all)


def _diff_subln(o, g, lam_init):
    of = o.astype(jnp.float32)
    y = of * lax.rsqrt(jnp.mean(jnp.square(of), axis=-1, keepdims=True) + RMS_EPS) * g * (1.0 - lam_init)
    return y.reshape(o.shape[0], o.shape[1], D_ATTN).astype(o.dtype)


def _short_conv(u, b_gate, c_gate, g, w):
    v = c_gate * u
    T = u.shape[1]
    vp = jnp.pad(v, ((0, 0), (1, 1), (0, 0)))
    y = vp[:, :T] * w[0] + vp[:, 1:T + 1] * w[1] + vp[:, 2:] * w[2]
    return jax.nn.silu(g) * (b_gate * y)


def _multiscale_pool(u, g, pool_w_l, pool_scale_l):
    B, T, _ = u.shape
    ug = u.reshape(B, T, N_POOL_GROUPS, POOL_GROUP).astype(jnp.float32)
    csum = jnp.concatenate([jnp.zeros_like(ug[:, :1]), jnp.cumsum(ug, axis=1)], axis=1)
    t = jnp.arange(T)
    diffs = []
    for gi, w in enumerate(POOL_WINDOWS):
        lo = jnp.clip(t - w // 2, 0, T)
        hi = jnp.clip(t + w - w // 2, 0, T)
        mean = (csum[:, hi, gi] - csum[:, lo, gi]) / (hi - lo).astype(jnp.float32)[None, :, None]
        diffs.append(mean - ug[:, :, gi])
    d = jnp.stack(diffs, axis=2).astype(u.dtype)
    y = jnp.einsum('btgc,gcd->btgd', d, pool_w_l).reshape(B, T, D_POOL) * pool_scale_l
    return jax.nn.silu(g) * y


def _mix_output(parts, att, lam_init, conv_w_l, subln_g_l, pool_w_l, pool_scale_l, w_out_l):
    cu, cb, cc, cg, _q, _k, _v, ag, pu, pg = parts
    y_conv = _short_conv(cu, cb, cc, cg, conv_w_l)
    y_attn = jax.nn.silu(ag) * _diff_subln(att, subln_g_l, lam_init)
    y_pool = _multiscale_pool(pu, pg, pool_w_l, pool_scale_l)
    return jnp.concatenate([y_conv, y_attn, y_pool], axis=-1) @ w_out_l


def setup_inputs(seed: int = 0) -> dict:
    key = jax.random.key(seed)
    ks = jax.random.split(key, 18)
    f32 = jnp.float32

    def nrm(k, shape, s):
        return s * jax.random.normal(k, shape, f32)

    return {
        'x': nrm(ks[0], (BATCH, SEQ, D_MODEL), 1.0),
        'c': nrm(ks[1], (BATCH, D_MODEL), 1.0),
        'ctx': nrm(ks[2], (BATCH, CTX_LEN, D_MODEL), 1.0),
        'c_ctx': nrm(ks[3], (D_MODEL,), 1.0),
        'w_mod': nrm(ks[4], (DEPTH, D_MODEL, 3 * D_MODEL), 0.5 * D_MODEL ** -0.5),
        'b_mod': nrm(ks[5], (DEPTH, 3 * D_MODEL), 0.02),
        'w_in': nrm(ks[6], (DEPTH, D_MODEL, D_IN), D_MODEL ** -0.5),
        'conv_w': nrm(ks[7], (DEPTH, CONV_W, D_CONV), CONV_W ** -0.5),
        'lam_q1': nrm(ks[8], (DEPTH, QK_DIM), 0.1),
        'lam_k1': nrm(ks[9], (DEPTH, QK_DIM), 0.1),
        'lam_q2': nrm(ks[10], (DEPTH, QK_DIM), 0.1),
        'lam_k2': nrm(ks[11], (DEPTH, QK_DIM), 0.1),
        'subln_g': 1.0 + nrm(ks[12], (DEPTH, V_DIM), 0.02),
        'pool_w': nrm(ks[13], (DEPTH, N_POOL_GROUPS, POOL_GROUP, POOL_GROUP), POOL_GROUP ** -0.5),
        'pool_scale': 1.0 + nrm(ks[14], (DEPTH, D_POOL), 0.02),
        'w_out': nrm(ks[15], (DEPTH, D_MIX, D_MODEL), DEEPNORM_BETA * D_MIX ** -0.5),
        'ln_g': 1.0 + nrm(ks[16], (DEPTH, D_MODEL), 0.02),
        'ln_b': nrm(ks[17], (DEPTH, D_MODEL), 0.02),
    }


def reference(x, c, ctx, c_ctx, w_mod, b_mod, w_in, conv_w, lam_q1, lam_k1, lam_q2, lam_k2,
              subln_g, pool_w, pool_scale, w_out, ln_g, ln_b):
    B, L, _ = x.shape
    ROWS = L // GRID_W
    rows = jnp.repeat(jnp.arange(ROWS, dtype=jnp.int32), GRID_W)
    cols = jnp.broadcast_to(jnp.arange(GRID_W, dtype=jnp.int32)[None, :], (ROWS, GRID_W)).reshape(-1)
    n_blk = L // Q_BLOCK
    xl, xc = x, ctx
    for l in range(DEPTH):
        last = l == DEPTH - 1
        sh_l, sc_l, g_l = jnp.split(jax.nn.silu(c) @ w_mod[l] + b_mod[l], 3, axis=-1)
        sh_c, sc_c, g_c = jnp.split(jax.nn.silu(c_ctx) @ w_mod[l] + b_mod[l], 3, axis=-1)
        hl = xl * (1.0 + sc_l[:, None, :]) + sh_l[:, None, :]
        hc = xc * (1.0 + sc_c) + sh_c
        lam_init = 0.8 - 0.6 * math.exp(-0.3 * l)
        lam = (jnp.exp(jnp.sum(lam_q1[l].astype(jnp.float32) * lam_k1[l].astype(jnp.float32)))
               - jnp.exp(jnp.sum(lam_q2[l].astype(jnp.float32) * lam_k2[l].astype(jnp.float32)))
               + lam_init)
        parts_l = jnp.split(hl @ w_in[l], SPLIT_POINTS, axis=-1)
        ql = _rope_axial(_qk_heads(parts_l[4]), rows, cols)
        kl = _rope_axial(_qk_heads(parts_l[5]), rows, cols)
        vl = _v_heads(parts_l[6])
        if last:
            kc, vc = jnp.split(hc @ w_in[l][:, ATT_K_OFF:ATT_V_END], 2, axis=-1)
            parts_c = None
        else:
            parts_c = jnp.split(hc @ w_in[l], SPLIT_POINTS, axis=-1)
            kc, vc = parts_c[5], parts_c[6]
        kc = _qk_heads(kc)
        vc = _v_heads(vc)
        k_all = jnp.concatenate([kc, kl], axis=1)
        v_all = jnp.concatenate([vc, vl], axis=1)
        q_blocks = ql.reshape(B, n_blk, Q_BLOCK, N_HEADS, 2, QK_DIM).swapaxes(0, 1)
        att_l = lax.map(lambda qb: _diff_attn(qb, k_all, v_all, lam), q_blocks)
        att_l = att_l.swapaxes(0, 1).reshape(B, L, N_HEADS, V_DIM)
        out_l = _mix_output(parts_l, att_l, lam_init, conv_w[l], subln_g[l], pool_w[l], pool_scale[l], w_out[l])
        xl_new = _layernorm(DEEPNORM_ALPHA * xl + g_l[:, None, :] * out_l, ln_g[l], ln_b[l])
        if not last:
            att_c = _diff_attn(_qk_heads(parts_c[4]), kc, vc, lam)
            out_c = _mix_output(parts_c, att_c, lam_init, conv_w[l], subln_g[l], pool_w[l], pool_scale[l], w_out[l])
            xc = _layernorm(DEEPNORM_ALPHA * xc + g_c * out_c, ln_g[l], ln_b[l])
        xl = xl_new
    return xl
```

```cpp
#include <hip/hip_runtime.h>
#include <hip/hip_cooperative_groups.h>
#include <cstdio>
#include <cstdint>
namespace cg = cooperative_groups;
__device__ __forceinline__ int otid() { int t = threadIdx.x; asm volatile("" : "+v"(t)); return t; }
namespace pg8 {
#define PG8_LAS __attribute__((address_space(3)))
typedef unsigned short bf16_t;
typedef short bf16x8 __attribute__((ext_vector_type(8)));
typedef float f32x4 __attribute__((ext_vector_type(4)));
typedef unsigned u32x4 __attribute__((ext_vector_type(4)));
constexpr int BM = 256, BK = 64, HALF = 128, HTB = HALF * BK * 2  , STAGE_BYTES = 8 * HTB, NXCD = 8, WGM = 8;

__host__ __device__ __forceinline__ int lds_byte(int r, int c) { const int st = (r >> 4) * 2 + (c >> 5), rr = r & 15, cc = c & 31, ob = rr * 64 + cc * 2; return st * 1024 + (ob ^ (((ob >> 9) & 1) << 5)); }
__host__ __device__ __forceinline__ void stage_rc(int b, int& R, int& C) { const int st = b / 1024, sb = b % 1024, swz = sb ^ (((sb >> 9) & 1) << 5); R = (st >> 1) * 16 + swz / 64; C = (st & 1) * 32 + (swz % 64) / 2; }
__host__ __device__ __forceinline__ int perm32(int rho) { const int n = rho >> 4, i = rho & 15; return 8 * (i >> 2) + 4 * n + (i & 3); }

struct Unit { int pm, pn; };
struct Gemm { const bf16_t* A; const bf16_t* Bt; int M, N, K; };

struct StaticOrder {
    int nM, nN, nwg, G, c;
    __host__ __device__ void init(int M, int N, int G_, int c_) { nM = M / BM; nN = N / BM; nwg = nM * nN; G = G_; c = c_; }
    __host__ __device__ bool next(int i, Unit& u) const {
        const long L = (long)i * G + c; if (L >= nwg) return false;
        int wgid = (int)L; { const int q = nwg / NXCD, r = nwg % NXCD, xcd = wgid % NXCD, off = wgid / NXCD; wgid = (xcd < r ? xcd * (q + 1) : r * (q + 1) + (xcd - r) * q) + off; }
        const int nig = WGM * nN, gid = wgid / nig, fm = gid * WGM, gsz = (nM - fm) < WGM ? (nM - fm) : WGM;
        u.pm = fm + ((wgid % nig) % gsz); u.pn = (wgid % nig) / gsz; return true;
    }
    __device__ __forceinline__ void a_ready(const Unit&) const {}
    __device__ __forceinline__ void done(const Unit&) const {}
};

__device__ __forceinline__ unsigned cvt_pk_bf16(float lo, float hi) { unsigned r; asm volatile("v_cvt_pk_bf16_f32 %0, %1, %2" : "=v"(r) : "v"(lo), "v"(hi)); return r; }

template <class Epi, class Sched, bool ALIGN_EPI = false, bool SP2 = false>
__device__ __forceinline__ void gemm_phase(PG8_LAS unsigned char* lds, const Gemm g, const Sched& S, const Epi& E) {
    const int tid = otid(), wid = __builtin_amdgcn_readfirstlane(tid >> 6), lane = tid & 63, wr = wid >> 2, wc = wid & 3, fr = lane & 15, fq = lane >> 4;
    const int K = g.K, nt = K / BK;
    unsigned voffA[2], voffB[2];
#pragma unroll
    for (int i = 0; i < 2; ++i) { int R, C; stage_rc(tid * 16 + i * 8192, R, C); const int Rb = Epi::PERM ? ((R & ~31) + perm32(R & 31)) : R;
        voffA[i] = (unsigned)(R * K + C) * 2u; voffB[i] = (unsigned)(Rb * K + C) * 2u; }
    const size_t kstep = (size_t)(BK * 2);
    const size_t hstep = (size_t)HALF * K * 2;
    const size_t tstep = 2 * hstep;
    const unsigned ldsw = (unsigned)wid * 1024u;
    const int aoff = lds_byte(wr * 64 + fr, fq * 8), boff = lds_byte(wc * 32 + fr, fq * 8);
#define PG8_SA(b, h) (((b) * 2 + (h)) * HTB)
#define PG8_SB(b, h) ((4 + (b) * 2 + (h)) * HTB)
#define PG8_STAGE(bufoff, gbase, voff) do { _Pragma("unroll") for (int _i = 0; _i < 2; ++_i) \
        __builtin_amdgcn_global_load_lds((const unsigned*)((const char*)(gbase) + (voff)[_i]), (PG8_LAS unsigned*)(lds + (bufoff) + ldsw + _i * 8192), 16, 0, 0); } while (0)
#define PG8_LDA(dst, b, h) do { _Pragma("unroll") for (int m = 0; m < 4; ++m) _Pragma("unroll") for (int k = 0; k < 2; ++k) dst[m][k] = *(const PG8_LAS bf16x8*)(lds + PG8_SA(b, h) + aoff + m * 2048 + k * 1024); } while (0)
#define PG8_LDB(dst, b, h) do { _Pragma("unroll") for (int n = 0; n < 2; ++n) _Pragma("unroll") for (int k = 0; k < 2; ++k) dst[n][k] = *(const PG8_LAS bf16x8*)(lds + PG8_SB(b, h) + boff + n * 2048 + k * 1024); } while (0)
#define PG8_MMA(ai, bj, At, Bt) do { __builtin_amdgcn_s_setprio(1); _Pragma("unroll") for (int m = 0; m < 4; ++m) _Pragma("unroll") for (int n = 0; n < 2; ++n) _Pragma("unroll") for (int k = 0; k < 2; ++k) \
        acc[ai][bj][m][n] = __builtin_amdgcn_mfma_f32_16x16x32_bf16(Bt[n][k], At[m][k], acc[ai][bj][m][n], 0, 0, 0); __builtin_amdgcn_s_setprio(0); } while (0)
#define PG8_WAIT_V(n) asm volatile("s_waitcnt vmcnt(" #n ")" ::: "memory")
#define PG8_WAIT_L(n) asm volatile("s_waitcnt lgkmcnt(" #n ")" ::: "memory")
#define PG8_BAR __builtin_amdgcn_s_barrier()
#define PG8_SCHED __builtin_amdgcn_sched_barrier(0)
    Unit cur, nxt; int ui = 0;
    if (!S.next(0, cur)) return;
    f32x4 acc[2][2][4][2];
#pragma unroll
    for (int a = 0; a < 2; ++a)
#pragma unroll
        for (int b = 0; b < 2; ++b)
#pragma unroll
            for (int m = 0; m < 4; ++m)
#pragma unroll
                for (int n = 0; n < 2; ++n) acc[a][b][m][n] = (f32x4){0.f, 0.f, 0.f, 0.f};
    bf16x8 At[4][2], B0[2][2], B1[2][2];
    const char* cA = (const char*)g.A + (size_t)cur.pm * tstep; const char* cB = (const char*)g.Bt + (size_t)cur.pn * tstep;
    S.a_ready(cur);
    if constexpr (SP2) {
        PG8_STAGE(PG8_SB(0, 0), cB, voffB); PG8_STAGE(PG8_SB(0, 1), cB + hstep, voffB); PG8_STAGE(PG8_SA(0, 0), cA, voffA); PG8_STAGE(PG8_SA(0, 1), cA + hstep, voffA);
        if (wr == 1) PG8_BAR;
        PG8_WAIT_V(2); PG8_BAR;
        PG8_STAGE(PG8_SB(1, 0), cB + kstep, voffB); PG8_STAGE(PG8_SA(1, 0), cA + kstep, voffA); PG8_STAGE(PG8_SB(1, 1), cB + hstep + kstep, voffB);
        PG8_WAIT_V(6); PG8_BAR;
    } else {
        PG8_STAGE(PG8_SB(0, 0), cB, voffB); PG8_STAGE(PG8_SA(0, 0), cA, voffA); PG8_STAGE(PG8_SB(0, 1), cB + hstep, voffB); PG8_STAGE(PG8_SA(0, 1), cA + hstep, voffA);
        if (wr == 1) PG8_BAR;
        PG8_WAIT_V(4); PG8_BAR;
        PG8_STAGE(PG8_SB(1, 0), cB + kstep, voffB); PG8_STAGE(PG8_SA(1, 0), cA + kstep, voffA); PG8_STAGE(PG8_SB(1, 1), cB + hstep + kstep, voffB);
        PG8_WAIT_V(6); PG8_BAR;
    }
    for (;;) {
        const bool has_next = S.next(ui + 1, nxt);
        const char* nA = has_next ? (const char*)g.A + (size_t)nxt.pm * tstep : cA; const char* nB = has_next ? (const char*)g.Bt + (size_t)nxt.pn * tstep : cB;
        for (int t = 0; t < nt; t += 2) {
            const bool last = (t == nt - 2);
            const char* a1 = cA + (size_t)(t + 1) * kstep;
            const char* a2 = last ? nA : cA + (size_t)(t + 2) * kstep; const char* b2 = last ? nB : cB + (size_t)(t + 2) * kstep;
            const char* a3 = a2 + kstep; const char* b3 = b2 + kstep;
            if (last && has_next) S.a_ready(nxt);
            if constexpr (SP2) {
            PG8_LDB(B0, 0, 0); PG8_LDB(B1, 0, 1); PG8_SCHED; PG8_LDA(At, 0, 0); PG8_STAGE(PG8_SA(1, 1), a1 + hstep, voffA);
            PG8_WAIT_V(8); PG8_WAIT_L(0); PG8_BAR; PG8_MMA(0, 0, At, B0); PG8_MMA(0, 1, At, B1); PG8_BAR; PG8_SCHED;
            PG8_LDA(At, 0, 1); PG8_STAGE(PG8_SB(0, 0), b2, voffB); PG8_STAGE(PG8_SB(0, 1), b2 + hstep, voffB); PG8_STAGE(PG8_SA(0, 0), a2, voffA);
            PG8_WAIT_V(8); PG8_WAIT_L(0); PG8_BAR; PG8_MMA(1, 0, At, B0); PG8_MMA(1, 1, At, B1); PG8_BAR; PG8_SCHED;
            PG8_LDB(B0, 1, 0); PG8_LDB(B1, 1, 1); PG8_SCHED; PG8_LDA(At, 1, 0); PG8_STAGE(PG8_SA(0, 1), a2 + hstep, voffA);
            PG8_WAIT_V(8); PG8_WAIT_L(0); PG8_BAR; PG8_MMA(0, 0, At, B0); PG8_MMA(0, 1, At, B1); PG8_BAR; PG8_SCHED;
            PG8_LDA(At, 1, 1); PG8_STAGE(PG8_SB(1, 0), b3, voffB); PG8_STAGE(PG8_SB(1, 1), b3 + hstep, voffB); PG8_STAGE(PG8_SA(1, 0), a3, voffA);
            PG8_WAIT_V(8); PG8_WAIT_L(0); PG8_BAR; PG8_MMA(1, 0, At, B0); PG8_MMA(1, 1, At, B1); PG8_BAR; PG8_SCHED;
            } else {
            PG8_LDB(B0, 0, 0); PG8_SCHED; PG8_LDA(At, 0, 0); PG8_STAGE(PG8_SA(1, 1), a1 + hstep, voffA);
            PG8_WAIT_L(8); PG8_BAR; PG8_WAIT_L(0); PG8_MMA(0, 0, At, B0); PG8_BAR; PG8_SCHED;
            PG8_LDB(B1, 0, 1); PG8_STAGE(PG8_SB(0, 0), b2, voffB);
            PG8_BAR; PG8_WAIT_L(0); PG8_MMA(0, 1, At, B1); PG8_BAR;
            PG8_LDA(At, 0, 1); PG8_STAGE(PG8_SA(0, 0), a2, voffA);
            PG8_BAR; PG8_WAIT_L(0); PG8_MMA(1, 0, At, B0); PG8_BAR; PG8_SCHED;
            PG8_STAGE(PG8_SB(0, 1), b2 + hstep, voffB);
            PG8_WAIT_V(6); PG8_BAR; PG8_MMA(1, 1, At, B1); PG8_BAR;
            PG8_LDB(B0, 1, 0); PG8_SCHED; PG8_LDA(At, 1, 0); PG8_STAGE(PG8_SA(0, 1), a2 + hstep, voffA);
            PG8_WAIT_L(8); PG8_BAR; PG8_WAIT_L(0); PG8_MMA(0, 0, At, B0); PG8_BAR; PG8_SCHED;
            PG8_LDB(B1, 1, 1); PG8_STAGE(PG8_SB(1, 0), b3, voffB);
            PG8_BAR; PG8_WAIT_L(0); PG8_MMA(0, 1, At, B1); PG8_BAR;
            PG8_LDA(At, 1, 1); PG8_STAGE(PG8_SA(1, 0), a3, voffA);
            PG8_BAR; PG8_WAIT_L(0); PG8_MMA(1, 0, At, B0); PG8_BAR; PG8_SCHED;
            PG8_STAGE(PG8_SB(1, 1), b3 + hstep, voffB);
            PG8_WAIT_V(6); PG8_BAR; PG8_MMA(1, 1, At, B1); PG8_BAR;
            }
        }
        if constexpr (ALIGN_EPI) { if (wr == 0) PG8_BAR; }
        if constexpr (!Epi::AFTER_DRAIN) { E(acc, cur, wr, wc, fr, fq); S.done(cur); }
        if (!has_next) break;
#pragma unroll
        for (int a = 0; a < 2; ++a)
#pragma unroll
            for (int b = 0; b < 2; ++b)
#pragma unroll
                for (int m = 0; m < 4; ++m)
#pragma unroll
                    for (int n = 0; n < 2; ++n) acc[a][b][m][n] = (f32x4){0.f, 0.f, 0.f, 0.f};
        cur = nxt; cA = nA; cB = nB; ++ui;
        if constexpr (ALIGN_EPI) { if (wr == 1) PG8_BAR; }
    }
    PG8_WAIT_V(0);
    if constexpr (!ALIGN_EPI) { if (wr == 0) PG8_BAR; }
    PG8_BAR;
    if constexpr (Epi::AFTER_DRAIN) { E.fused(acc, cur, wr, wc, fr, fq, lds, wid, lane); S.done(cur); }
#undef PG8_SA
#undef PG8_SB
#undef PG8_STAGE
#undef PG8_LDA
#undef PG8_LDB
#undef PG8_MMA
#undef PG8_WAIT_V
#undef PG8_WAIT_L
#undef PG8_BAR
#undef PG8_SCHED
}
}

using pg8::bf16_t; using pg8::bf16x8; using pg8::f32x4; using pg8::u32x4;
typedef float f32x16 __attribute__((ext_vector_type(16)));
typedef short s16x4 __attribute__((ext_vector_type(4)));
typedef unsigned u32x2 __attribute__((ext_vector_type(2)));
#define LAS __attribute__((address_space(3)))

constexpr int DM = 2048, NB = 4, SEQ = 4096, CTXL = 256, NLAT = NB * SEQ, NCTX = NB * CTXL, MROWS = NLAT + NCTX, DIN = 7168;
constexpr int C_Q = 2048, C_K = 3072, C_V = 4096, C_AG = 5120, C_PU = 6144, C_PG = 6656;
constexpr float LN_EPS = 1e-5f, RMS_EPS = 1e-5f;
constexpr float ALPHA = 1.4142135623730951f;
constexpr float QSCALE = 0.125f * 1.4426950408889634f;
constexpr int NTHREADS = 512;
constexpr int LDS_BYTES = 131072 + 1024;

constexpr size_t OFF_WTIN = 1u << 20;
constexpr size_t OFF_WTOUT = OFF_WTIN + (size_t)2 * DIN * DM * 2;
constexpr size_t OFF_PWT = OFF_WTOUT + (size_t)2 * DM * DM * 2;
constexpr size_t OFF_MODP = OFF_PWT + 262144;
constexpr size_t OFF_MODF = OFF_MODP + 983040;
constexpr size_t OFF_ROPE = OFF_MODF + 245760;
constexpr size_t OFF_HY = OFF_ROPE + 8192;
constexpr size_t OFF_P = OFF_HY + (size_t)MROWS * DM * 2;
constexpr size_t OFF_ZC = OFF_P + (size_t)MROWS * DIN * 2;
constexpr size_t OFF_O1 = OFF_ZC + (size_t)NCTX * DM * 4;
constexpr size_t WS_END = OFF_O1 + (size_t)256 * 256 * 128 * 4;

struct Params {
    const float *x, *c, *ctx, *c_ctx, *w_mod, *b_mod, *w_in, *conv_w, *lq1, *lk1, *lq2, *lk2, *subln_g, *pool_w, *pool_scale, *w_out, *ln_g, *ln_b;
    float* out; unsigned char* ws;
};

__device__ __forceinline__ float silu_f(float v) { return v / (1.f + __expf(-v)); }
__device__ __forceinline__ float bf2f(unsigned short b) { return __uint_as_float(((unsigned)b) << 16); }
__device__ __forceinline__ float bflo(unsigned w) { return __uint_as_float(w << 16); }
__device__ __forceinline__ float bfhi(unsigned w) { return __uint_as_float(w & 0xffff0000u); }
__device__ __forceinline__ unsigned pk2(float lo, float hi) { return pg8::cvt_pk_bf16(lo, hi); }
__device__ __forceinline__ float wave_sum(float v) {
#pragma unroll
    for (int o = 32; o >= 1; o >>= 1) v += __shfl_xor(v, o);
    return v;
}

__device__ __forceinline__ int rope_src(int j) { const int part = j >> 5, jj = j & 31; return part * 32 + (jj & 1) * 16 + (jj >> 1); }

__device__ __forceinline__ void transpose_tile(const float* __restrict__ src, int K, int N, bf16_t* __restrict__ dst, int k0, int n0, bool permq, LAS float* tile) {
    const int tid = otid();
    { const int r = tid >> 4, c4 = (tid & 15) * 4;
#pragma unroll
      for (int i = 0; i < 2; ++i) { const int k = r + 32 * i; const f32x4 v = *(const f32x4*)(src + (size_t)(k0 + k) * N + n0 + c4);
          tile[k * 65 + c4 + 0] = v[0]; tile[k * 65 + c4 + 1] = v[1]; tile[k * 65 + c4 + 2] = v[2]; tile[k * 65 + c4 + 3] = v[3]; } }
    __syncthreads();
    { const int n = tid >> 3, kc = (tid & 7) * 8; const int ns = permq ? rope_src(n) : n;
      float f[8];
#pragma unroll
      for (int j = 0; j < 8; ++j) f[j] = tile[(kc + j) * 65 + ns];
      u32x4 w; w.x = pk2(f[0], f[1]); w.y = pk2(f[2], f[3]); w.z = pk2(f[4], f[5]); w.w = pk2(f[6], f[7]);
      *(u32x4*)(dst + (size_t)(n0 + n) * K + k0 + kc) = w; }
    __syncthreads();
}

__device__ __forceinline__ void gemv_item(const Params& p, int item, LAS float* lds) {
    const int l = item / 192, rem = item % 192, kq = rem / 48, cgp = rem % 48, tid = threadIdx.x;
    LAS float* s = lds; LAS float* red = lds + 2560;
    float* MODP = (float*)(p.ws + OFF_MODP);
#pragma unroll
    for (int r = 0; r < 5; ++r) { const int k = kq * 512 + tid; const float v = (r < 4) ? p.c[r * DM + k] : p.c_ctx[k]; s[r * 512 + tid] = silu_f(v); }
    __syncthreads();
    const int kl = tid >> 5, c4 = tid & 31;
    const float* W = p.w_mod + (size_t)l * DM * 6144 + (size_t)(kq * 512) * 6144 + cgp * 128 + c4 * 4;
    f32x4 acc[5];
#pragma unroll
    for (int r = 0; r < 5; ++r) acc[r] = (f32x4){0.f, 0.f, 0.f, 0.f};
#pragma unroll 4
    for (int i = 0; i < 32; ++i) { const int k = kl + 16 * i; const f32x4 w = *(const f32x4*)(W + (size_t)k * 6144);
#pragma unroll
        for (int r = 0; r < 5; ++r) { const float sv = s[r * 512 + k]; acc[r] += w * sv; } }
#pragma unroll
    for (int r = 0; r < 5; ++r) { LAS float* q = red + (kl * 5 + r) * 128 + c4 * 4; q[0] = acc[r][0]; q[1] = acc[r][1]; q[2] = acc[r][2]; q[3] = acc[r][3]; }
    __syncthreads();
    for (int o = tid; o < 640; o += NTHREADS) { const int r = o >> 7, cc = o & 127; float sum = 0.f;
#pragma unroll
        for (int k2 = 0; k2 < 16; ++k2) sum += red[(k2 * 5 + r) * 128 + cc];
        MODP[(size_t)((l * 4 + kq) * 5 + r) * 6144 + cgp * 128 + cc] = sum; }
    __syncthreads();
}

constexpr int N_GEMV = 384, N_TIN = 3584, N_TOUT = 1024, N_TPOOL = 32;
constexpr int IT_TIN = N_GEMV, IT_TOUT = IT_TIN + 2 * N_TIN, IT_TPOOL = IT_TOUT + 2 * N_TOUT, IT_ROPE = IT_TPOOL + N_TPOOL, N_ITEMS0 = IT_ROPE + 1;

__device__ __forceinline__ void phase0(const Params& p, LAS unsigned char* lds) {
    LAS float* fl = (LAS float*)lds;
    for (int it = blockIdx.x; it < N_ITEMS0; it += gridDim.x) {
        if (it < IT_TIN) gemv_item(p, it, fl);
        else if (it < IT_TOUT) { const int q = it - IT_TIN, l = q / N_TIN, t = q % N_TIN, tk = t / 112, tn = t % 112;
            transpose_tile(p.w_in + (size_t)l * DM * DIN, DM, DIN, (bf16_t*)(p.ws + OFF_WTIN) + (size_t)l * DIN * DM, tk * 64, tn * 64, (tn * 64 >= C_Q && tn * 64 < C_V), fl); }
        else if (it < IT_TPOOL) { const int q = it - IT_TOUT, l = q / N_TOUT, t = q % N_TOUT, tk = t / 32, tn = t % 32;
            transpose_tile(p.w_out + (size_t)l * DM * DM, DM, DM, (bf16_t*)(p.ws + OFF_WTOUT) + (size_t)l * DM * DM, tk * 64, tn * 64, false, fl); }
        else if (it < IT_ROPE) { const int q = it - IT_TPOOL, mtx = q >> 2, tk = (q >> 1) & 1, tn = q & 1;
            transpose_tile(p.pool_w + (size_t)mtx * 128 * 128, 128, 128, (bf16_t*)(p.ws + OFF_PWT) + (size_t)mtx * 128 * 128, tk * 64, tn * 64, false, fl); }
        else { float* rope = (float*)(p.ws + OFF_ROPE);
            for (int e = otid(); e < 1024; e += NTHREADS) { const int pos = e >> 4, i = e & 15;
                const float inv = exp2f(-(float)i * 0.830482023721841f);
                const float ang = (float)pos * inv; float sn, cs; sincosf(ang, &sn, &cs);
                rope[2 * e] = cs; rope[2 * e + 1] = sn; } }
    }
}

__device__ __forceinline__ void phase_mod0(const Params& p) {
    const int tid = otid(), G = gridDim.x, blk = blockIdx.x;
    const float* MODP = (const float*)(p.ws + OFF_MODP); float* MODF = (float*)(p.ws + OFF_MODF);
    bf16_t* H = (bf16_t*)(p.ws + OFF_HY);
    for (int idx = blk * NTHREADS + tid; idx < 2 * 5 * 6144; idx += G * NTHREADS) {
        const int l = idx / 30720, rem = idx % 30720, r = rem / 6144, n = rem % 6144; float v = p.b_mod[l * 6144 + n];
#pragma unroll
        for (int kq = 0; kq < 4; ++kq) v += MODP[(size_t)((l * 4 + kq) * 5 + r) * 6144 + n];
        MODF[idx] = v; }
    const int per = (MROWS + G - 1) / G; int r0 = blk * per, r1 = r0 + per; if (r1 > MROWS) r1 = MROWS;
    const int col = 4 * tid;
    while (r0 < r1) {
        const int b = r0 < NLAT ? r0 / SEQ : 4; int rend = r0 < NLAT ? (b + 1) * SEQ : MROWS; if (rend > r1) rend = r1;
        f32x4 sh = *(const f32x4*)(p.b_mod + col), sc = *(const f32x4*)(p.b_mod + 2048 + col);
#pragma unroll
        for (int kq = 0; kq < 4; ++kq) { sh += *(const f32x4*)(MODP + (size_t)(kq * 5 + b) * 6144 + col); sc += *(const f32x4*)(MODP + (size_t)(kq * 5 + b) * 6144 + 2048 + col); }
        sc += 1.f;
#pragma unroll 4
        for (int row = r0; row < rend; ++row) {
            const float* src = row < NLAT ? p.x + (size_t)row * DM : p.ctx + (size_t)(row - NLAT) * DM;
            const f32x4 v = *(const f32x4*)(src + col); const f32x4 h = v * sc + sh;
            u32x2 w; w.x = pk2(h[0], h[1]); w.y = pk2(h[2], h[3]); *(u32x2*)(H + (size_t)row * DM + col) = w; }
        r0 = rend;
    }
}

struct OrderX {
    pg8::StaticOrder base; int nextra, epm0, epn0, epnn;
    __device__ __forceinline__ bool next(int i, pg8::Unit& u) const {
        const long L = (long)i * base.G + base.c; if (L < base.nwg) return base.next(i, u);
        const int e = (int)(L - base.nwg); if (e >= nextra) return false; u.pm = epm0 + e / epnn; u.pn = epn0 + e % epnn; return true; }
    __device__ __forceinline__ void a_ready(const pg8::Unit&) const {}
    __device__ __forceinline__ void done(const pg8::Unit&) const {}
};

struct EpiIn {
    static constexpr bool PERM = true, AFTER_DRAIN = false;
    bf16_t* P; const float* rope;
    __device__ __forceinline__ void operator()(const f32x4 (&acc)[2][2][4][2], const pg8::Unit& u, int wr, int wc, int fr, int fq) const {
        const bool isq = (u.pn >= 8 && u.pn < 12), isk = (u.pn >= 12 && u.pn < 16);
        const bool dorope = (isq || isk) && (u.pm < 64);
        const float qs = isq ? QSCALE : 1.f;
#pragma unroll
        for (int ai = 0; ai < 2; ++ai)
#pragma unroll
            for (int m = 0; m < 4; ++m) {
                const int row = u.pm * 256 + ai * 128 + wr * 64 + m * 16 + fr; const int t = row & 4095, prow = t >> 6, pcol = t & 63;
#pragma unroll
                for (int bj = 0; bj < 2; ++bj) {
                    const int col0 = u.pn * 256 + bj * 128 + wc * 32 + 8 * fq;
                    f32x4 v0 = acc[ai][bj][m][0], v1 = acc[ai][bj][m][1];
                    if (dorope) { const int part = (col0 >> 5) & 1, i0 = (col0 & 31) >> 1, pos = part ? pcol : prow; const float* rp = rope + (pos * 16 + i0) * 2;
                        const f32x4 c0 = *(const f32x4*)rp, c1 = *(const f32x4*)(rp + 4); float a, b;
                        a = v0[0]; b = v0[1]; v0[0] = a * c0[0] - b * c0[1]; v0[1] = a * c0[1] + b * c0[0];
                        a = v0[2]; b = v0[3]; v0[2] = a * c0[2] - b * c0[3]; v0[3] = a * c0[3] + b * c0[2];
                        a = v1[0]; b = v1[1]; v1[0] = a * c1[0] - b * c1[1]; v1[1] = a * c1[1] + b * c1[0];
                        a = v1[2]; b = v1[3]; v1[2] = a * c1[2] - b * c1[3]; v1[3] = a * c1[3] + b * c1[2]; }
                    v0 = v0 * qs; v1 = v1 * qs;
                    u32x4 w; w.x = pk2(v0[0], v0[1]); w.y = pk2(v0[2], v0[3]); w.z = pk2(v1[0], v1[1]); w.w = pk2(v1[2], v1[3]);
                    *(u32x4*)(P + (size_t)row * DIN + col0) = w; } }
    }
};

struct EpiOut {
    static constexpr bool PERM = true, AFTER_DRAIN = false;
    const float* xlat; const float* xctx; float* olat; float* octx; const float* gate;
    __device__ __forceinline__ void operator()(const f32x4 (&acc)[2][2][4][2], const pg8::Unit& u, int wr, int wc, int fr, int fq) const {
        const bool lat = u.pm < 64;
#pragma unroll
        for (int ai = 0; ai < 2; ++ai)
#pragma unroll
            for (int m = 0; m < 4; ++m) {
                const int row = u.pm * 256 + ai * 128 + wr * 64 + m * 16 + fr; const int b = lat ? (row >> 12) : 4;
                const float* xr = lat ? xlat + (size_t)row * DM : xctx + (size_t)(row - NLAT) * DM;
                float* orow = lat ? olat + (size_t)row * DM : octx + (size_t)(row - NLAT) * DM;
                const float* gr = gate + b * 6144;
#pragma unroll
                for (int bj = 0; bj < 2; ++bj) {
                    const int col0 = u.pn * 256 + bj * 128 + wc * 32 + 8 * fq;
                    const f32x4 g0 = *(const f32x4*)(gr + col0), g1 = *(const f32x4*)(gr + col0 + 4);
                    const f32x4 x0 = *(const f32x4*)(xr + col0), x1 = *(const f32x4*)(xr + col0 + 4);
                    const f32x4 z0 = x0 * ALPHA + g0 * acc[ai][bj][m][0], z1 = x1 * ALPHA + g1 * acc[ai][bj][m][1];
                    *(f32x4*)(orow + col0) = z0; *(f32x4*)(orow + col0 + 4) = z1; } }
    }
};

namespace att {
constexpr int SHM_V = 16384, SHM_K = 8192;
constexpr int LDS_V = 0, LDS_K = 2 * SHM_V, LDS_WS = LDS_K + 2 * SHM_K, LDS_TOTAL = LDS_WS + 8 * 64 * 4;
constexpr float THRL = 8.f;
#define KSW(row, chunk) ((row) * 128 + ((((chunk) ^ (((row) >> 1) & 7))) << 4))
#define SBAR() __builtin_amdgcn_sched_barrier(0)
__device__ __forceinline__ int crow(int r, int hi) { return (r & 3) + 8 * (r >> 2) + 4 * hi; }
__device__ __forceinline__ unsigned cvtpk(float lo, float hi) { unsigned r; asm volatile("v_cvt_pk_bf16_f32 %0, %1, %2" : "=v"(r) : "v"(lo), "v"(hi)); return r; }

__device__ __forceinline__ void partialSM(f32x16& p0, f32x16& p1, float& m_reg, float& alpha) {
    float pmax = p0[0];
#pragma unroll
    for (int r = 1; r < 16; ++r) pmax = fmaxf(pmax, p0[r]);
#pragma unroll
    for (int r = 0; r < 16; ++r) pmax = fmaxf(pmax, p1[r]);
    { auto rr = __builtin_amdgcn_permlane32_swap(__float_as_uint(pmax), __float_as_uint(pmax), false, false);
      pmax = fmaxf(__uint_as_float(rr[0]), __uint_as_float(rr[1])); }
    float mn;
    if (__builtin_expect(__all(pmax - m_reg <= THRL), 1)) { mn = m_reg; alpha = 1.f; }
    else { mn = fmaxf(m_reg, pmax); alpha = __builtin_amdgcn_exp2f(m_reg - mn); m_reg = mn; }
#pragma unroll
    for (int r = 0; r < 16; ++r) { p0[r] -= mn; p1[r] -= mn; }
#pragma unroll
    for (int r = 0; r < 16; ++r) p0[r] = __builtin_amdgcn_exp2f(p0[r]);
}
__device__ __forceinline__ void finishSM(f32x16& p0, f32x16& p1, float alpha, float& l_reg, bf16x8& pa0, bf16x8& pa1, bf16x8& pa2, bf16x8& pa3) {
#pragma unroll
    for (int r = 0; r < 16; ++r) p1[r] = __builtin_amdgcn_exp2f(p1[r]);
    float ps = 0;
#pragma unroll
    for (int r = 0; r < 16; ++r) ps += p0[r];
#pragma unroll
    for (int r = 0; r < 16; ++r) ps += p1[r];
    { auto rr = __builtin_amdgcn_permlane32_swap(__float_as_uint(ps), __float_as_uint(ps), false, false);
      ps = __uint_as_float(rr[0]) + __uint_as_float(rr[1]); }
    l_reg = l_reg * alpha + ps;
#define PK4(P, BASE, OUT) do { unsigned a0 = cvtpk(P[BASE + 0], P[BASE + 1]), a1 = cvtpk(P[BASE + 2], P[BASE + 3]);   \
    unsigned b0 = cvtpk(P[BASE + 4], P[BASE + 5]), b1 = cvtpk(P[BASE + 6], P[BASE + 7]);                              \
    auto r0 = __builtin_amdgcn_permlane32_swap(a0, b0, false, false); auto r1 = __builtin_amdgcn_permlane32_swap(a1, b1, false, false); \
    u32x4 w = {r0[0], r1[0], r0[1], r1[1]}; OUT = *reinterpret_cast<bf16x8*>(&w); } while (0)
    PK4(p0, 0, pa0); PK4(p0, 8, pa1); PK4(p1, 0, pa2); PK4(p1, 8, pa3);
#undef PK4
}
__device__ __forceinline__ void qkt(f32x16& p0, f32x16& p1, const LAS char* Ks, const bf16x8* qr, int r32, int hi) {
    p0 = f32x16{}; p1 = f32x16{};
#pragma unroll
    for (int d0 = 0; d0 < 4; ++d0) { const int ch = d0 * 2 + hi;
        bf16x8 b0 = *(const LAS bf16x8*)(Ks + KSW(r32, ch));
        bf16x8 b1 = *(const LAS bf16x8*)(Ks + KSW(32 + r32, ch));
        p0 = __builtin_amdgcn_mfma_f32_32x32x16_bf16(b0, qr[d0], p0, 0, 0, 0);
        p1 = __builtin_amdgcn_mfma_f32_32x32x16_bf16(b1, qr[d0], p1, 0, 0, 0); }
}
__device__ __forceinline__ int v_st(int k, int c) { const int kk = (k & ~0xC) | ((k & 4) << 1) | ((k & 8) >> 1); return ((kk >> 3) * 4 + (c >> 5)) * 512 + ((kk & 7) * 32 + (c & 31)) * 2; }
__device__ __forceinline__ int v_rd_base(int lane) { return ((lane & 3) << 3) | (((lane >> 2) & 3) << 6) | (((lane >> 4) & 1) << 5) | (((lane >> 5) & 1) << 8); }
constexpr int v_rd_off(int d0, int ks, int half) { return d0 * 512 + ks * 4096 + half * 2048; }
template <int OFF> __device__ __forceinline__ s16x4 tr_read(int vb) {
    s16x4 r; asm volatile("ds_read_b64_tr_b16 %0, %1 offset:%2" : "=&v"(r) : "v"(vb), "i"(OFF) : "memory"); return r;
}
template <int D0> __device__ __forceinline__ void pv_one(f32x16& od, int vb, bf16x8 pa0, bf16x8 pa1, bf16x8 pa2, bf16x8 pa3) {
    const s16x4 l0 = tr_read<v_rd_off(D0, 0, 0)>(vb), h0 = tr_read<v_rd_off(D0, 0, 1)>(vb), l1 = tr_read<v_rd_off(D0, 1, 0)>(vb), h1 = tr_read<v_rd_off(D0, 1, 1)>(vb);
    const s16x4 l2 = tr_read<v_rd_off(D0, 2, 0)>(vb), h2 = tr_read<v_rd_off(D0, 2, 1)>(vb), l3 = tr_read<v_rd_off(D0, 3, 0)>(vb), h3 = tr_read<v_rd_off(D0, 3, 1)>(vb);
    asm volatile("s_waitcnt lgkmcnt(0)" ::: "memory"); SBAR();
#define PK(L, H) (bf16x8){L[0], L[1], L[2], L[3], H[0], H[1], H[2], H[3]}
    od = __builtin_amdgcn_mfma_f32_32x32x16_bf16(pa0, PK(l0, h0), od, 0, 0, 0);
    od = __builtin_amdgcn_mfma_f32_32x32x16_bf16(pa1, PK(l1, h1), od, 0, 0, 0);
    od = __builtin_amdgcn_mfma_f32_32x32x16_bf16(pa2, PK(l2, h2), od, 0, 0, 0);
    od = __builtin_amdgcn_mfma_f32_32x32x16_bf16(pa3, PK(l3, h3), od, 0, 0, 0);
#undef PK
}
__device__ __forceinline__ void pv_d0(f32x16* o, int vb, bf16x8 pa0, bf16x8 pa1, bf16x8 pa2, bf16x8 pa3) {
    pv_one<0>(o[0], vb, pa0, pa1, pa2, pa3); pv_one<1>(o[1], vb, pa0, pa1, pa2, pa3); pv_one<2>(o[2], vb, pa0, pa1, pa2, pa3); pv_one<3>(o[3], vb, pa0, pa1, pa2, pa3);
}

__device__ __forceinline__ void attn_map(const bf16_t* __restrict__ Qw, const bf16_t* __restrict__ Kc, const bf16_t* __restrict__ Vc, int ctx_row0, int lat_row0, int nct, int NT,
                                         LAS char* lds, f32x16 (&o)[4], float& l_out) {
    const int tid = otid(), wid = tid >> 6, lane = tid & 63, r32 = lane & 31, hi = lane >> 5;
    LAS char* V_lds = lds + LDS_V; LAS char* K_lds = lds + LDS_K;
    LAS float* ws = (LAS float*)(lds + LDS_WS) + wid * 64; LAS float* al_l = ws + 32;
    float m_reg = -1e30f, l_reg = 0;
#pragma unroll
    for (int d = 0; d < 4; ++d) o[d] = f32x16{};
    bf16x8 qr[4];
#pragma unroll
    for (int d0 = 0; d0 < 4; ++d0) qr[d0] = *reinterpret_cast<const bf16x8*>(Qw + d0 * 16);
    const int sr = tid >> 4, sc = (tid & 15) * 8, vst0 = v_st(sr, sc), vst1 = v_st(32 + sr, sc);
    const int kr = tid >> 3, kc = tid & 7, kst = KSW(kr, kc);
    const int vb0 = (int)(uintptr_t)V_lds + v_rd_base(lane);
    struct { bf16x8 vs0, vs1, ks0; } sr_[2];
#define KROW(t) (((t) < nct) ? (ctx_row0 + (t) * 64) : (lat_row0 + ((t) - nct) * 64))
#define SLOAD(i, t) do { const long rb_ = KROW(t); sr_[i].vs0 = *reinterpret_cast<const bf16x8*>(Vc + (rb_ + sr) * DIN + sc); sr_[i].vs1 = *reinterpret_cast<const bf16x8*>(Vc + (rb_ + 32 + sr) * DIN + sc); \
    sr_[i].ks0 = *reinterpret_cast<const bf16x8*>(Kc + (rb_ + kr) * DIN + kc * 8); } while (0)
#define SWRITE(b, i) do { *(LAS bf16x8*)(V_lds + (b) * SHM_V + vst0) = sr_[i].vs0; *(LAS bf16x8*)(V_lds + (b) * SHM_V + vst1) = sr_[i].vs1; \
    *(LAS bf16x8*)(K_lds + (b) * SHM_K + kst) = sr_[i].ks0; } while (0)
#define SWAIT() asm volatile("s_waitcnt vmcnt(3)" ::: "memory")
#define RESC(a) do { if (__any((a) < 1.f)) { if (hi == 0) al_l[r32] = (a); asm volatile("s_waitcnt lgkmcnt(0)" ::: "memory"); \
    _Pragma("unroll") for (int d = 0; d < 4; ++d) _Pragma("unroll") for (int r = 0; r < 16; ++r) o[d][r] *= al_l[crow(r, hi)]; } } while (0)
    f32x16 pA0, pA1, pB0, pB1; float alA, alB; bf16x8 pa0, pa1, pa2, pa3;
    constexpr int SE = 0, SO = 1;
    __syncthreads();
    SLOAD(SE, 0); asm volatile("s_waitcnt vmcnt(0)" ::: "memory"); SWRITE(0, SE); __syncthreads();
    qkt(pA0, pA1, K_lds, qr, r32, hi); partialSM(pA0, pA1, m_reg, alA);
    SLOAD(SO, 1); if (2 < NT) SLOAD(SE, 2);
    SWAIT(); SWRITE(1, SO); __syncthreads();
    for (int j = 1; j + 1 < NT; j += 2) {
        SBAR(); qkt(pB0, pB1, K_lds + SHM_K, qr, r32, hi);
        finishSM(pA0, pA1, alA, l_reg, pa0, pa1, pa2, pa3); SBAR();
        SLOAD(SO, j + 2); SBAR();
        pv_d0(o, vb0, pa0, pa1, pa2, pa3); partialSM(pB0, pB1, m_reg, alB);
        __syncthreads(); SWAIT(); SWRITE(0, SE);
        RESC(alB); __syncthreads();
        SBAR(); qkt(pA0, pA1, K_lds, qr, r32, hi);
        finishSM(pB0, pB1, alB, l_reg, pa0, pa1, pa2, pa3); SBAR();
        if (j + 3 < NT) SLOAD(SE, j + 3); SBAR();
        pv_d0(o, vb0 + SHM_V, pa0, pa1, pa2, pa3); partialSM(pA0, pA1, m_reg, alA);
        __syncthreads(); SWAIT(); SWRITE(1, SO);
        RESC(alA); __syncthreads();
    }
    SBAR(); qkt(pB0, pB1, K_lds + SHM_K, qr, r32, hi);
    finishSM(pA0, pA1, alA, l_reg, pa0, pa1, pa2, pa3); SBAR();
    pv_d0(o, vb0, pa0, pa1, pa2, pa3); partialSM(pB0, pB1, m_reg, alB);
    __syncthreads(); RESC(alB);
    finishSM(pB0, pB1, alB, l_reg, pa0, pa1, pa2, pa3); SBAR();
    pv_d0(o, vb0 + SHM_V, pa0, pa1, pa2, pa3);
    l_out = l_reg;
#undef KROW
#undef SLOAD
#undef SWRITE
#undef SWAIT
#undef RESC
}

constexpr int LDS_OB = 0, LDS_OA = 65536, LDS_ATT_END = LDS_OA + 65536;
static_assert(LDS_TOTAL <= LDS_OA, "attention LDS map");
__device__ __forceinline__ void attn_unit(const Params& p, int l, int h, int qrow0, int ctx_row0, int lat_row0, int nct, int NT, float lam, float oml, LAS char* lds) {
    const int tid = otid(), wid = tid >> 6, lane = tid & 63, r32 = lane & 31, hi = lane >> 5;
    const bf16_t* P = (const bf16_t*)(p.ws + OFF_P); bf16_t* Y = (bf16_t*)(p.ws + OFF_HY);
    LAS float* li_l = (LAS float*)(lds + LDS_WS) + wid * 64;
    f32x16 o[4]; float l_reg;
#ifndef MPN
#define MPN 2
#endif
#pragma unroll
    for (int mp = 0; mp < MPN; ++mp) {
        const bf16_t* Qw = P + (size_t)(qrow0 + wid * 32 + r32) * DIN + C_Q + h * 128 + mp * 64 + hi * 8;
        attn_map(Qw, P + C_K + h * 128 + mp * 64, P + C_V + h * 128, ctx_row0, lat_row0, nct, NT, lds, o, l_reg);
        if (hi == 0) li_l[r32] = l_reg; asm volatile("s_waitcnt lgkmcnt(0)" ::: "memory");
        float rli[16];
#pragma unroll
        for (int r = 0; r < 16; ++r) rli[r] = __builtin_amdgcn_rcpf(li_l[crow(r, hi)]);
        if (mp == 1) __syncthreads();
        LAS bf16_t* ol = (LAS bf16_t*)(lds + (mp == 0 ? LDS_OA : LDS_OB)) + (wid * 32 + 4 * hi) * 128 + r32;
#pragma unroll
        for (int r = 0; r < 16; ++r)
#pragma unroll
            for (int d0 = 0; d0 < 4; ++d0) ol[((r & 3) + 8 * (r >> 2)) * 128 + d0 * 32] = (bf16_t)(cvtpk(o[d0][r] * rli[r], 0.f) & 0xffffu);
        if (mp == 1) {
            asm volatile("s_waitcnt lgkmcnt(0)" ::: "memory");
            int c4 = r32 * 4; asm volatile("" : "+v"(c4));
            const f32x4 g4 = *(const f32x4*)(p.subln_g + l * 128 + c4) * oml;
            const LAS bf16_t* A = (const LAS bf16_t*)(lds + LDS_OA) + (wid * 32 + hi) * 128 + c4;
            const LAS bf16_t* B = (const LAS bf16_t*)(lds + LDS_OB) + (wid * 32 + hi) * 128 + c4;
            const bf16_t* agp = P + (size_t)(qrow0 + wid * 32 + hi) * DIN + C_AG + h * 128 + c4;
            bf16_t* yp = Y + (size_t)(qrow0 + wid * 32 + hi) * DM + 512 + h * 128 + c4;
#pragma unroll 2
            for (int st = 0; st < 16; ++st) {
                const u32x2 av = *(const LAS u32x2*)(A + st * 256), bv = *(const LAS u32x2*)(B + st * 256);
                const u32x2 ag = *(const u32x2*)(agp + (size_t)(st * 2) * DIN);
                const float f0 = bflo(av.x) - lam * bflo(bv.x), f1 = bfhi(av.x) - lam * bfhi(bv.x), f2 = bflo(av.y) - lam * bflo(bv.y), f3 = bfhi(av.y) - lam * bfhi(bv.y);
                float ss = (f0 * f0 + f1 * f1) + (f2 * f2 + f3 * f3);
#pragma unroll
                for (int off = 1; off < 32; off <<= 1) ss += __shfl_xor(ss, off);
                const float rstd = __builtin_amdgcn_rsqf(ss * (1.f / 128.f) + RMS_EPS);
                const float y0 = f0 * rstd * g4[0] * silu_f(bflo(ag.x)), y1 = f1 * rstd * g4[1] * silu_f(bfhi(ag.x));
                const float y2 = f2 * rstd * g4[2] * silu_f(bflo(ag.y)), y3 = f3 * rstd * g4[3] * silu_f(bfhi(ag.y));
                u32x2 w; w.x = cvtpk(y0, y1); w.y = cvtpk(y2, y3);
                *(u32x2*)(yp + (size_t)(st * 2) * DM) = w;
            }
        }
    }
}
#undef KSW
#undef SBAR
}

__device__ __forceinline__ void seq_bounds(int R0, int& s0, int& s1) { if (R0 < NLAT) { s0 = R0 & ~(SEQ - 1); s1 = s0 + SEQ; } else { s0 = NLAT + ((R0 - NLAT) & ~(CTXL - 1)); s1 = s0 + CTXL; } }

__device__ __forceinline__ void conv_item(const Params& p, int l, int rt) {
    const int tid = otid(), cp = tid & 255, half = tid >> 8, R0 = rt * 64; int s0, s1; seq_bounds(R0, s0, s1);
    const bf16_t* P = (const bf16_t*)(p.ws + OFF_P); bf16_t* Y = (bf16_t*)(p.ws + OFF_HY);
    const float* cw = p.conv_w + l * 3 * 512 + 2 * cp;
    const float w00 = cw[0], w01 = cw[1], w10 = cw[512], w11 = cw[513], w20 = cw[1024], w21 = cw[1025];
    const int ra = R0 + half * 32;
#define LDU(row, sect) (*(const unsigned*)(P + (size_t)(row) * DIN + (sect) * 512 + 2 * cp))
    float vp0 = 0.f, vp1 = 0.f, vc0, vc1;
    if (ra - 1 >= s0) { const unsigned u = LDU(ra - 1, 0), c = LDU(ra - 1, 2); vp0 = bflo(u) * bflo(c); vp1 = bfhi(u) * bfhi(c); }
    { const unsigned u = LDU(ra, 0), c = LDU(ra, 2); vc0 = bflo(u) * bflo(c); vc1 = bfhi(u) * bfhi(c); }
#pragma unroll 4
    for (int i = 0; i < 32; ++i) { const int row = ra + i; float vn0 = 0.f, vn1 = 0.f;
        if (row + 1 < s1) { const unsigned u = LDU(row + 1, 0), c = LDU(row + 1, 2); vn0 = bflo(u) * bflo(c); vn1 = bfhi(u) * bfhi(c); }
        const unsigned bg = LDU(row, 1), gg = LDU(row, 3);
        const float y0 = silu_f(bflo(gg)) * bflo(bg) * (w00 * vp0 + w10 * vc0 + w20 * vn0);
        const float y1 = silu_f(bfhi(gg)) * bfhi(bg) * (w01 * vp1 + w11 * vc1 + w21 * vn1);
        *(unsigned*)(Y + (size_t)row * DM + 2 * cp) = pk2(y0, y1);
        vp0 = vc0; vp1 = vc1; vc0 = vn0; vc1 = vn1; }
#undef LDU
}

__device__ __forceinline__ void pool_item(const Params& p, int l, int rt, int g, LAS unsigned char* lds) {
    const int tid = otid(), R0 = rt * 64; int s0, s1; seq_bounds(R0, s0, s1);
    const bf16_t* P = (const bf16_t*)(p.ws + OFF_P); bf16_t* Y = (bf16_t*)(p.ws + OFF_HY);
    LAS bf16_t* dt = (LAS bf16_t*)lds;
    { const int cp = tid & 63, rg = tid >> 6, hw = 1 << g, t0 = R0 + rg * 8;
#define LDU(row) (*(const unsigned*)(P + (size_t)(row) * DIN + C_PU + g * 128 + 2 * cp))
      int lo = t0 - hw; if (lo < s0) lo = s0; int hi = t0 + hw; if (hi > s1) hi = s1;
      float a0 = 0.f, a1 = 0.f;
      for (int j = lo; j < hi; ++j) { const unsigned u = LDU(j); a0 += bflo(u); a1 += bfhi(u); }
#pragma unroll
      for (int i = 0; i < 8; ++i) { const int t = t0 + i; const int lo_t = (t - hw < s0) ? s0 : t - hw, hi_t = (t + hw > s1) ? s1 : t + hw;
          const float inv = 1.f / (float)(hi_t - lo_t); const unsigned u = LDU(t);
          *(LAS unsigned*)(dt + (rg * 8 + i) * 136 + 2 * cp) = pk2(a0 * inv - bflo(u), a1 * inv - bfhi(u));
          if (t + hw < s1) { const unsigned un = LDU(t + hw); a0 += bflo(un); a1 += bfhi(un); }
          if (t - hw >= s0) { const unsigned uo = LDU(t - hw); a0 -= bflo(uo); a1 -= bfhi(uo); } }
#undef LDU
    }
    __syncthreads();
    { const int wid = tid >> 6, lane = tid & 63, mt = wid & 3, nh = wid >> 2, fr = lane & 15, fq = lane >> 4;
      const bf16_t* PWT = (const bf16_t*)(p.ws + OFF_PWT) + (size_t)(l * 4 + g) * 128 * 128;
      f32x4 acc[4];
#pragma unroll
      for (int n = 0; n < 4; ++n) acc[n] = (f32x4){0.f, 0.f, 0.f, 0.f};
#pragma unroll
      for (int ks = 0; ks < 4; ++ks) { const bf16x8 a = *(const LAS bf16x8*)(dt + (mt * 16 + fr) * 136 + ks * 32 + fq * 8);
#pragma unroll
          for (int n = 0; n < 4; ++n) { const bf16x8 b = *(const bf16x8*)(PWT + (size_t)(nh * 64 + n * 16 + fr) * 128 + ks * 32 + fq * 8);
              acc[n] = __builtin_amdgcn_mfma_f32_16x16x32_bf16(a, b, acc[n], 0, 0, 0); } }
#pragma unroll
      for (int n = 0; n < 4; ++n)
#pragma unroll
          for (int j = 0; j < 4; ++j) { const int row = R0 + mt * 16 + 4 * fq + j, col = g * 128 + nh * 64 + n * 16 + fr;
              const float pg = bf2f(P[(size_t)row * DIN + C_PG + col]);
              const float y = silu_f(pg) * p.pool_scale[l * 512 + col] * acc[n][j];
              Y[(size_t)row * DM + 1536 + col] = (bf16_t)(pk2(y, 0.f) & 0xffffu); } }
    __syncthreads();
}

__device__ __forceinline__ void phase_mix(const Params& p, int l, LAS unsigned char* lds) {
    const int G = gridDim.x, blk = blockIdx.x, lane = otid() & 63;
    const float lam_init = (l == 0) ? 0.2f : 0.35550906759096935f;
    float lam;
    { const float a = p.lq1[l * 64 + lane] * p.lk1[l * 64 + lane], b = p.lq2[l * 64 + lane] * p.lk2[l * 64 + lane];
      lam = __expf(wave_sum(a)) - __expf(wave_sum(b)) + lam_init; }
    const int nrt = (l == 0) ? MROWS / 64 : NLAT / 64;
    const int n_conv = nrt, n_pool = nrt * 4, n_cattn = (l == 0) ? 32 : 0;
#ifndef NO_CONV
    for (int it = blk; it < n_conv; it += G) conv_item(p, l, it);
#endif
#ifndef NO_POOL
    for (int it = blk; it < n_pool; it += G) pool_item(p, l, it >> 2, it & 3, lds);
#endif
#ifndef NO_LATTN
    for (int u = blk; u < 512 + n_cattn; u += G) {
        int h, qrow0, crow0, lrow0, NT;
        if (u < 512) {
            int bh, qb;
            if (G == 256) { const int i = u >> 8, xcd = blk & 7, j = blk >> 3; bh = xcd * 4 + i * 2 + (j >> 4); qb = j & 15; }
            else { bh = u >> 4; qb = u & 15; }
            const int b = bh >> 3; h = bh & 7; qrow0 = b * SEQ + qb * 256; crow0 = NLAT + b * CTXL; lrow0 = b * SEQ; NT = 68;
        } else { const int q = u - 512, b = q >> 3; h = q & 7; qrow0 = NLAT + b * CTXL; crow0 = qrow0; lrow0 = qrow0; NT = 4; }
        att::attn_unit(p, l, h, qrow0, crow0, lrow0, 4, NT, lam, 1.f - lam_init, (LAS char*)lds);
    }
#endif
    __syncthreads();
}

__device__ __forceinline__ void phase_ln(const Params& p, int l, bool final) {
    const int G = gridDim.x, tid = otid(), wid = tid >> 6, lane = tid & 63;
    const int nrows = final ? NLAT : MROWS;
    const float* MODF = (const float*)(p.ws + OFF_MODF); bf16_t* H = (bf16_t*)(p.ws + OFF_HY);
    const float* lg = p.ln_g + l * DM; const float* lb = p.ln_b + l * DM;
    for (int row = blockIdx.x * 8 + wid; row < nrows; row += G * 8) {
        const bool lat = row < NLAT;
        float* src = lat ? p.out + (size_t)row * DM : (float*)(p.ws + OFF_ZC) + (size_t)(row - NLAT) * DM;
        f32x4 v[8]; float s = 0.f;
#pragma unroll
        for (int i = 0; i < 8; ++i) { v[i] = *(const f32x4*)(src + (i * 64 + lane) * 4); s += (v[i][0] + v[i][1]) + (v[i][2] + v[i][3]); }
        const float mean = wave_sum(s) * (1.f / DM); float q = 0.f;
#pragma unroll
        for (int i = 0; i < 8; ++i) { const f32x4 d = v[i] - mean; q += (d[0] * d[0] + d[1] * d[1]) + (d[2] * d[2] + d[3] * d[3]); }
        const float rstd = __builtin_amdgcn_rsqf(wave_sum(q) * (1.f / DM) + LN_EPS);
        const int b = lat ? (row >> 12) : 4;
#pragma unroll
        for (int i = 0; i < 8; ++i) { const int col = (i * 64 + lane) * 4;
            const f32x4 xn = (v[i] - mean) * rstd * *(const f32x4*)(lg + col) + *(const f32x4*)(lb + col);
            if (lat) *(f32x4*)(src + col) = xn;
            if (!final) { const f32x4 sh = *(const f32x4*)(MODF + (size_t)(5 + b) * 6144 + col), sc = *(const f32x4*)(MODF + (size_t)(5 + b) * 6144 + 2048 + col);
                const f32x4 h = xn * (sc + 1.f) + sh; u32x2 w; w.x = pk2(h[0], h[1]); w.y = pk2(h[2], h[3]); *(u32x2*)(H + (size_t)row * DM + col) = w; } }
    }
}

__global__ void __launch_bounds__(NTHREADS, 2) hybrid_fwd(Params p) {
    extern __shared__ __attribute__((aligned(16))) unsigned char lds_g[];
    LAS unsigned char* lds = (LAS unsigned char*)lds_g;
    cg::grid_group grid = cg::this_grid();
    const int G = gridDim.x;

#ifndef PH_MASK
#define PH_MASK 0xFF
#endif
    if constexpr (PH_MASK & 1) phase0(p, lds);
    grid.sync();
    if constexpr (PH_MASK & 2) phase_mod0(p);
    grid.sync();
#pragma unroll 1
    for (int l = 0; l < 2; ++l) {
        if constexpr (PH_MASK & 4) {
            pg8::Gemm g{(const bf16_t*)(p.ws + OFF_HY), (const bf16_t*)(p.ws + OFF_WTIN) + (size_t)l * DIN * DM, (l == 0) ? MROWS : NLAT, DIN, DM};
            OrderX S; S.base.init((l == 0) ? MROWS : NLAT, DIN, G, (int)blockIdx.x); S.nextra = (l == 0) ? 0 : 32; S.epm0 = 64; S.epn0 = 12; S.epnn = 8;
            EpiIn E{(bf16_t*)(p.ws + OFF_P), (const float*)(p.ws + OFF_ROPE)};
            pg8::gemm_phase<EpiIn, OrderX, true, true>(lds, g, S, E);
        }
        grid.sync();
        if constexpr (PH_MASK & 8) phase_mix(p, l, lds);
        grid.sync();
        if constexpr (PH_MASK & 16) {
            pg8::Gemm g{(const bf16_t*)(p.ws + OFF_HY), (const bf16_t*)(p.ws + OFF_WTOUT) + (size_t)l * DM * DM, (l == 0) ? MROWS : NLAT, DM, DM};
            OrderX S; S.base.init((l == 0) ? MROWS : NLAT, DM, G, (int)blockIdx.x); S.nextra = 0; S.epm0 = 0; S.epn0 = 0; S.epnn = 1;
            EpiOut E{(l == 0) ? p.x : p.out, p.ctx, p.out, (float*)(p.ws + OFF_ZC), (const float*)(p.ws + OFF_MODF) + (size_t)l * 5 * 6144 + 4096};
            pg8::gemm_phase<EpiOut, OrderX, true, true>(lds, g, S, E);
        }
        grid.sync();
        if constexpr (PH_MASK & 32) phase_ln(p, l, l == 1);
        if (l == 0) grid.sync();
    }
}

extern "C" void kernel_launch(void* const* d_in, const int* in_sizes, int n_in, void* d_out, int out_size, void* d_ws, size_t ws_size, hipStream_t stream) {
    static int grid_blocks = 0;
    if (grid_blocks == 0) {
        if (n_in != 18 || in_sizes[0] != NLAT * DM || out_size != NLAT * DM || ws_size < WS_END) {
            fprintf(stderr, "kernel_launch: shape/workspace mismatch: n_in %d in0 %d out %d ws %zu (need %zu)\n", n_in, n_in > 0 ? in_sizes[0] : -1, out_size, ws_size, (size_t)WS_END); grid_blocks = -1; return; }
        int dev = 0, cus = 0, per_cu = 0;
        hipGetDevice(&dev); hipDeviceGetAttribute(&cus, hipDeviceAttributeMultiprocessorCount, dev);
        if (hipFuncSetAttribute((const void*)hybrid_fwd, hipFuncAttributeMaxDynamicSharedMemorySize, LDS_BYTES) != hipSuccess) { fprintf(stderr, "kernel_launch: hipFuncSetAttribute failed\n"); grid_blocks = -1; return; }
        if (hipOccupancyMaxActiveBlocksPerMultiprocessor(&per_cu, (const void*)hybrid_fwd, NTHREADS, LDS_BYTES) != hipSuccess || per_cu < 1) { fprintf(stderr, "kernel_launch: occupancy query gave %d\n", per_cu); per_cu = 1; }
        (void)hipGetLastError();
        grid_blocks = cus * 1;
        if (grid_blocks > 256) grid_blocks = 256;
    }
    if (grid_blocks < 0) return;
    Params p{};
    p.x = (const float*)d_in[0]; p.c = (const float*)d_in[1]; p.ctx = (const float*)d_in[2]; p.c_ctx = (const float*)d_in[3]; p.w_mod = (const float*)d_in[4]; p.b_mod = (const float*)d_in[5];
    p.w_in = (const float*)d_in[6]; p.conv_w = (const float*)d_in[7]; p.lq1 = (const float*)d_in[8]; p.lk1 = (const float*)d_in[9]; p.lq2 = (const float*)d_in[10]; p.lk2 = (const float*)d_in[11];
    p.subln_g = (const float*)d_in[12]; p.pool_w = (const float*)d_in[13]; p.pool_scale = (const float*)d_in[14]; p.w_out = (const float*)d_in[15]; p.ln_g = (const float*)d_in[16]; p.ln_b = (const float*)d_in[17];
    p.out = (float*)d_out; p.ws = (unsigned char*)d_ws;
    void* args[] = {&p};
    const hipError_t e = hipLaunchCooperativeKernel((const void*)hybrid_fwd, dim3(grid_blocks), dim3(NTHREADS), args, LDS_BYTES, stream);
    if (e != hipSuccess) fprintf(stderr, "kernel_launch: cooperative launch failed: %s (grid %d)\n", hipGetErrorString(e), grid_blocks);
}
```

```cpp
#include <hip/hip_runtime.h>
#include <hip/hip_cooperative_groups.h>
#include <cstdio>
#include <cstdint>
namespace cg = cooperative_groups;
__device__ __forceinline__ int otid() { int t = threadIdx.x; asm volatile("" : "+v"(t)); return t; }
namespace pg8 {
#define PG8_LAS __attribute__((address_space(3)))
typedef unsigned short bf16_t;
typedef short bf16x8 __attribute__((ext_vector_type(8)));
typedef float f32x4 __attribute__((ext_vector_type(4)));
typedef unsigned u32x4 __attribute__((ext_vector_type(4)));
constexpr int BM = 256, BK = 64, HALF = 128, HTB = HALF * BK * 2  , STAGE_BYTES = 8 * HTB, NXCD = 8, WGM = 8;

__host__ __device__ __forceinline__ int lds_byte(int r, int c) { const int st = (r >> 4) * 2 + (c >> 5), rr = r & 15, cc = c & 31, ob = rr * 64 + cc * 2; return st * 1024 + (ob ^ (((ob >> 9) & 1) << 5)); }
__host__ __device__ __forceinline__ void stage_rc(int b, int& R, int& C) { const int st = b / 1024, sb = b % 1024, swz = sb ^ (((sb >> 9) & 1) << 5); R = (st >> 1) * 16 + swz / 64; C = (st & 1) * 32 + (swz % 64) / 2; }
__host__ __device__ __forceinline__ int perm32(int rho) { const int n = rho >> 4, i = rho & 15; return 8 * (i >> 2) + 4 * n + (i & 3); }

struct Unit { int pm, pn; };
struct Gemm { const bf16_t* A; const bf16_t* Bt; int M, N, K; };

struct StaticOrder {
    int nM, nN, nwg, G, c;
    __host__ __device__ void init(int M, int N, int G_, int c_) { nM = M / BM; nN = N / BM; nwg = nM * nN; G = G_; c = c_; }
    __host__ __device__ bool next(int i, Unit& u) const {
        const long L = (long)i * G + c; if (L >= nwg) return false;
        int wgid = (int)L; { const int q = nwg / NXCD, r = nwg % NXCD, xcd = wgid % NXCD, off = wgid / NXCD; wgid = (xcd < r ? xcd * (q + 1) : r * (q + 1) + (xcd - r) * q) + off; }
        const int nig = WGM * nN, gid = wgid / nig, fm = gid * WGM, gsz = (nM - fm) < WGM ? (nM - fm) : WGM;
        u.pm = fm + ((wgid % nig) % gsz); u.pn = (wgid % nig) / gsz; return true;
    }
    __device__ __forceinline__ void a_ready(const Unit&) const {}
    __device__ __forceinline__ void done(const Unit&) const {}
};

__device__ __forceinline__ unsigned cvt_pk_bf16(float lo, float hi) { unsigned r; asm volatile("v_cvt_pk_bf16_f32 %0, %1, %2" : "=v"(r) : "v"(lo), "v"(hi)); return r; }

template <class Epi, class Sched, bool ALIGN_EPI = false, bool SP2 = false>
__device__ __forceinline__ void gemm_phase(PG8_LAS unsigned char* lds, const Gemm g, const Sched& S, const Epi& E) {
    const int tid = otid(), wid = __builtin_amdgcn_readfirstlane(tid >> 6), lane = tid & 63, wr = wid >> 2, wc = wid & 3, fr = lane & 15, fq = lane >> 4;
    const int K = g.K, nt = K / BK;
    unsigned voffA[2], voffB[2];
#pragma unroll
    for (int i = 0; i < 2; ++i) { int R, C; stage_rc(tid * 16 + i * 8192, R, C); const int Rb = Epi::PERM ? ((R & ~31) + perm32(R & 31)) : R;
        voffA[i] = (unsigned)(R * K + C) * 2u; voffB[i] = (unsigned)(Rb * K + C) * 2u; }
    const size_t kstep = (size_t)(BK * 2);
    const size_t hstep = (size_t)HALF * K * 2;
    const size_t tstep = 2 * hstep;
    const unsigned ldsw = (unsigned)wid * 1024u;
    const int aoff = lds_byte(wr * 64 + fr, fq * 8), boff = lds_byte(wc * 32 + fr, fq * 8);
#define PG8_SA(b, h) (((b) * 2 + (h)) * HTB)
#define PG8_SB(b, h) ((4 + (b) * 2 + (h)) * HTB)
#define PG8_STAGE(bufoff, gbase, voff) do { _Pragma("unroll") for (int _i = 0; _i < 2; ++_i) \
        __builtin_amdgcn_global_load_lds((const unsigned*)((const char*)(gbase) + (voff)[_i]), (PG8_LAS unsigned*)(lds + (bufoff) + ldsw + _i * 8192), 16, 0, 0); } while (0)
#define PG8_LDA(dst, b, h) do { _Pragma("unroll") for (int m = 0; m < 4; ++m) _Pragma("unroll") for (int k = 0; k < 2; ++k) dst[m][k] = *(const PG8_LAS bf16x8*)(lds + PG8_SA(b, h) + aoff + m * 2048 + k * 1024); } while (0)
#define PG8_LDB(dst, b, h) do { _Pragma("unroll") for (int n = 0; n < 2; ++n) _Pragma("unroll") for (int k = 0; k < 2; ++k) dst[n][k] = *(const PG8_LAS bf16x8*)(lds + PG8_SB(b, h) + boff + n * 2048 + k * 1024); } while (0)
#define PG8_MMA(ai, bj, At, Bt) do { __builtin_amdgcn_s_setprio(1); _Pragma("unroll") for (int m = 0; m < 4; ++m) _Pragma("unroll") for (int n = 0; n < 2; ++n) _Pragma("unroll") for (int k = 0; k < 2; ++k) \
        acc[ai][bj][m][n] = __builtin_amdgcn_mfma_f32_16x16x32_bf16(Bt[n][k], At[m][k], acc[ai][bj][m][n], 0, 0, 0); __builtin_amdgcn_s_setprio(0); } while (0)
#define PG8_WAIT_V(n) asm volatile("s_waitcnt vmcnt(" #n ")" ::: "memory")
#define PG8_WAIT_L(n) asm volatile("s_waitcnt lgkmcnt(" #n ")" ::: "memory")
#define PG8_BAR __builtin_amdgcn_s_barrier()
#define PG8_SCHED __builtin_amdgcn_sched_barrier(0)
    Unit cur, nxt; int ui = 0;
    if (!S.next(0, cur)) return;
    f32x4 acc[2][2][4][2];
#pragma unroll
    for (int a = 0; a < 2; ++a)
#pragma unroll
        for (int b = 0; b < 2; ++b)
#pragma unroll
            for (int m = 0; m < 4; ++m)
#pragma unroll
                for (int n = 0; n < 2; ++n) acc[a][b][m][n] = (f32x4){0.f, 0.f, 0.f, 0.f};
    bf16x8 At[4][2], B0[2][2], B1[2][2];
    const char* cA = (const char*)g.A + (size_t)cur.pm * tstep; const char* cB = (const char*)g.Bt + (size_t)cur.pn * tstep;
    S.a_ready(cur);
    if constexpr (SP2) {
        PG8_STAGE(PG8_SB(0, 0), cB, voffB); PG8_STAGE(PG8_SB(0, 1), cB + hstep, voffB); PG8_STAGE(PG8_SA(0, 0), cA, voffA); PG8_STAGE(PG8_SA(0, 1), cA + hstep, voffA);
        if (wr == 1) PG8_BAR;
        PG8_WAIT_V(2); PG8_BAR;
        PG8_STAGE(PG8_SB(1, 0), cB + kstep, voffB); PG8_STAGE(PG8_SA(1, 0), cA + kstep, voffA); PG8_STAGE(PG8_SB(1, 1), cB + hstep + kstep, voffB);
        PG8_WAIT_V(6); PG8_BAR;
    } else {
        PG8_STAGE(PG8_SB(0, 0), cB, voffB); PG8_STAGE(PG8_SA(0, 0), cA, voffA); PG8_STAGE(PG8_SB(0, 1), cB + hstep, voffB); PG8_STAGE(PG8_SA(0, 1), cA + hstep, voffA);
        if (wr == 1) PG8_BAR;
        PG8_WAIT_V(4); PG8_BAR;
        PG8_STAGE(PG8_SB(1, 0), cB + kstep, voffB); PG8_STAGE(PG8_SA(1, 0), cA + kstep, voffA); PG8_STAGE(PG8_SB(1, 1), cB + hstep + kstep, voffB);
        PG8_WAIT_V(6); PG8_BAR;
    }
    for (;;) {
        const bool has_next = S.next(ui + 1, nxt);
        const char* nA = has_next ? (const char*)g.A + (size_t)nxt.pm * tstep : cA; const char* nB = has_next ? (const char*)g.Bt + (size_t)nxt.pn * tstep : cB;
        for (int t = 0; t < nt; t += 2) {
            const bool last = (t == nt - 2);
            const char* a1 = cA + (size_t)(t + 1) * kstep;
            const char* a2 = last ? nA : cA + (size_t)(t + 2) * kstep; const char* b2 = last ? nB : cB + (size_t)(t + 2) * kstep;
            const char* a3 = a2 + kstep; const char* b3 = b2 + kstep;
            if (last && has_next) S.a_ready(nxt);
            if constexpr (SP2) {
            PG8_LDB(B0, 0, 0); PG8_LDB(B1, 0, 1); PG8_SCHED; PG8_LDA(At, 0, 0); PG8_STAGE(PG8_SA(1, 1), a1 + hstep, voffA);
            PG8_WAIT_V(8); PG8_WAIT_L(0); PG8_BAR; PG8_MMA(0, 0, At, B0); PG8_MMA(0, 1, At, B1); PG8_BAR; PG8_SCHED;
            PG8_LDA(At, 0, 1); PG8_STAGE(PG8_SB(0, 0), b2, voffB); PG8_STAGE(PG8_SB(0, 1), b2 + hstep, voffB); PG8_STAGE(PG8_SA(0, 0), a2, voffA);
            PG8_WAIT_V(8); PG8_WAIT_L(0); PG8_BAR; PG8_MMA(1, 0, At, B0); PG8_MMA(1, 1, At, B1); PG8_BAR; PG8_SCHED;
            PG8_LDB(B0, 1, 0); PG8_LDB(B1, 1, 1); PG8_SCHED; PG8_LDA(At, 1, 0); PG8_STAGE(PG8_SA(0, 1), a2 + hstep, voffA);
            PG8_WAIT_V(8); PG8_WAIT_L(0); PG8_BAR; PG8_MMA(0, 0, At, B0); PG8_MMA(0, 1, At, B1); PG8_BAR; PG8_SCHED;
            PG8_LDA(At, 1, 1); PG8_STAGE(PG8_SB(1, 0), b3, voffB); PG8_STAGE(PG8_SB(1, 1), b3 + hstep, voffB); PG8_STAGE(PG8_SA(1, 0), a3, voffA);
            PG8_WAIT_V(8); PG8_WAIT_L(0); PG8_BAR; PG8_MMA(1, 0, At, B0); PG8_MMA(1, 1, At, B1); PG8_BAR; PG8_SCHED;
            } else {
            PG8_LDB(B0, 0, 0); PG8_SCHED; PG8_LDA(At, 0, 0); PG8_STAGE(PG8_SA(1, 1), a1 + hstep, voffA);
            PG8_WAIT_L(8); PG8_BAR; PG8_WAIT_L(0); PG8_MMA(0, 0, At, B0); PG8_BAR; PG8_SCHED;
            PG8_LDB(B1, 0, 1); PG8_STAGE(PG8_SB(0, 0), b2, voffB);
            PG8_BAR; PG8_WAIT_L(0); PG8_MMA(0, 1, At, B1); PG8_BAR;
            PG8_LDA(At, 0, 1); PG8_STAGE(PG8_SA(0, 0), a2, voffA);
            PG8_BAR; PG8_WAIT_L(0); PG8_MMA(1, 0, At, B0); PG8_BAR; PG8_SCHED;
            PG8_STAGE(PG8_SB(0, 1), b2 + hstep, voffB);
            PG8_WAIT_V(6); PG8_BAR; PG8_MMA(1, 1, At, B1); PG8_BAR;
            PG8_LDB(B0, 1, 0); PG8_SCHED; PG8_LDA(At, 1, 0); PG8_STAGE(PG8_SA(0, 1), a2 + hstep, voffA);
            PG8_WAIT_L(8); PG8_BAR; PG8_WAIT_L(0); PG8_MMA(0, 0, At, B0); PG8_BAR; PG8_SCHED;
            PG8_LDB(B1, 1, 1); PG8_STAGE(PG8_SB(1, 0), b3, voffB);
            PG8_BAR; PG8_WAIT_L(0); PG8_MMA(0, 1, At, B1); PG8_BAR;
            PG8_LDA(At, 1, 1); PG8_STAGE(PG8_SA(1, 0), a3, voffA);
            PG8_BAR; PG8_WAIT_L(0); PG8_MMA(1, 0, At, B0); PG8_BAR; PG8_SCHED;
            PG8_STAGE(PG8_SB(1, 1), b3 + hstep, voffB);
            PG8_WAIT_V(6); PG8_BAR; PG8_MMA(1, 1, At, B1); PG8_BAR;
            }
        }
        if constexpr (ALIGN_EPI) { if (wr == 0) PG8_BAR; }
        if constexpr (!Epi::AFTER_DRAIN) { E(acc, cur, wr, wc, fr, fq); S.done(cur); }
        if (!has_next) break;
#pragma unroll
        for (int a = 0; a < 2; ++a)
#pragma unroll
            for (int b = 0; b < 2; ++b)
#pragma unroll
                for (int m = 0; m < 4; ++m)
#pragma unroll
                    for (int n = 0; n < 2; ++n) acc[a][b][m][n] = (f32x4){0.f, 0.f, 0.f, 0.f};
        cur = nxt; cA = nA; cB = nB; ++ui;
        if constexpr (ALIGN_EPI) { if (wr == 1) PG8_BAR; }
    }
    PG8_WAIT_V(0);
    if constexpr (!ALIGN_EPI) { if (wr == 0) PG8_BAR; }
    PG8_BAR;
    if constexpr (Epi::AFTER_DRAIN) { E.fused(acc, cur, wr, wc, fr, fq, lds, wid, lane); S.done(cur); }
#undef PG8_SA
#undef PG8_SB
#undef PG8_STAGE
#undef PG8_LDA
#undef PG8_LDB
#undef PG8_MMA
#undef PG8_WAIT_V
#undef PG8_WAIT_L
#undef PG8_BAR
#undef PG8_SCHED
}
}

using pg8::bf16_t; using pg8::bf16x8; using pg8::f32x4; using pg8::u32x4;
typedef float f32x16 __attribute__((ext_vector_type(16)));
typedef short s16x4 __attribute__((ext_vector_type(4)));
typedef unsigned u32x2 __attribute__((ext_vector_type(2)));
#define LAS __attribute__((address_space(3)))

constexpr int DM = 2048, NB = 4, SEQ = 4096, CTXL = 256, NLAT = NB * SEQ, NCTX = NB * CTXL, MROWS = NLAT + NCTX, DIN = 7168;
constexpr int C_Q = 2048, C_K = 3072, C_V = 4096, C_AG = 5120, C_PU = 6144, C_PG = 6656;
constexpr float LN_EPS = 1e-5f, RMS_EPS = 1e-5f;
constexpr float ALPHA = 1.4142135623730951f;
constexpr float QSCALE = 0.125f * 1.4426950408889634f;
constexpr int NTHREADS = 512;
constexpr int LDS_BYTES = 147456 + 1024;

constexpr size_t OFF_WTIN = 1u << 20;
constexpr size_t OFF_WTOUT = OFF_WTIN + (size_t)2 * DIN * DM * 2;
constexpr size_t OFF_PWT = OFF_WTOUT + (size_t)2 * DM * DM * 2;
constexpr size_t OFF_MODP = OFF_PWT + 262144;
constexpr size_t OFF_MODF = OFF_MODP + 983040;
constexpr size_t OFF_ROPE = OFF_MODF + 245760;
constexpr size_t OFF_HY = OFF_ROPE + 8192;
constexpr size_t OFF_P = OFF_HY + (size_t)MROWS * DM * 2;
constexpr size_t OFF_ZC = OFF_P + (size_t)MROWS * DIN * 2;
constexpr size_t OFF_O1 = OFF_ZC + (size_t)NCTX * DM * 4;
constexpr size_t WS_END = OFF_O1 + (size_t)256 * 256 * 128 * 4;

struct Params {
    const float *x, *c, *ctx, *c_ctx, *w_mod, *b_mod, *w_in, *conv_w, *lq1, *lk1, *lq2, *lk2, *subln_g, *pool_w, *pool_scale, *w_out, *ln_g, *ln_b;
    float* out; unsigned char* ws;
};

__device__ __forceinline__ float silu_f(float v) { return v / (1.f + __expf(-v)); }
__device__ __forceinline__ float bf2f(unsigned short b) { return __uint_as_float(((unsigned)b) << 16); }
__device__ __forceinline__ float bflo(unsigned w) { return __uint_as_float(w << 16); }
__device__ __forceinline__ float bfhi(unsigned w) { return __uint_as_float(w & 0xffff0000u); }
__device__ __forceinline__ unsigned pk2(float lo, float hi) { return pg8::cvt_pk_bf16(lo, hi); }
__device__ __forceinline__ float wave_sum(float v) {
#pragma unroll
    for (int o = 32; o >= 1; o >>= 1) v += __shfl_xor(v, o);
    return v;
}

__device__ __forceinline__ int rope_src(int j) { const int part = j >> 5, jj = j & 31; return part * 32 + (jj & 1) * 16 + (jj >> 1); }

__device__ __forceinline__ void transpose_tile(const float* __restrict__ src, int K, int N, bf16_t* __restrict__ dst, int k0, int n0, bool permq, LAS float* tile) {
    const int tid = otid();
    { const int r = tid >> 4, c4 = (tid & 15) * 4;
#pragma unroll
      for (int i = 0; i < 2; ++i) { const int k = r + 32 * i; const f32x4 v = *(const f32x4*)(src + (size_t)(k0 + k) * N + n0 + c4);
          tile[k * 65 + c4 + 0] = v[0]; tile[k * 65 + c4 + 1] = v[1]; tile[k * 65 + c4 + 2] = v[2]; tile[k * 65 + c4 + 3] = v[3]; } }
    __syncthreads();
    { const int n = tid >> 3, kc = (tid & 7) * 8; const int ns = permq ? rope_src(n) : n;
      float f[8];
#pragma unroll
      for (int j = 0; j < 8; ++j) f[j] = tile[(kc + j) * 65 + ns];
      u32x4 w; w.x = pk2(f[0], f[1]); w.y = pk2(f[2], f[3]); w.z = pk2(f[4], f[5]); w.w = pk2(f[6], f[7]);
      *(u32x4*)(dst + (size_t)(n0 + n) * K + k0 + kc) = w; }
    __syncthreads();
}

__device__ __forceinline__ void gemv_item(const Params& p, int item, LAS float* lds) {
    const int l = item / 192, rem = item % 192, kq = rem / 48, cgp = rem % 48, tid = threadIdx.x;
    LAS float* s = lds; LAS float* red = lds + 2560;
    float* MODP = (float*)(p.ws + OFF_MODP);
#pragma unroll
    for (int r = 0; r < 5; ++r) { const int k = kq * 512 + tid; const float v = (r < 4) ? p.c[r * DM + k] : p.c_ctx[k]; s[r * 512 + tid] = silu_f(v); }
    __syncthreads();
    const int kl = tid >> 5, c4 = tid & 31;
    const float* W = p.w_mod + (size_t)l * DM * 6144 + (size_t)(kq * 512) * 6144 + cgp * 128 + c4 * 4;
    f32x4 acc[5];
#pragma unroll
    for (int r = 0; r < 5; ++r) acc[r] = (f32x4){0.f, 0.f, 0.f, 0.f};
#pragma unroll 4
    for (int i = 0; i < 32; ++i) { const int k = kl + 16 * i; const f32x4 w = *(const f32x4*)(W + (size_t)k * 6144);
#pragma unroll
        for (int r = 0; r < 5; ++r) { const float sv = s[r * 512 + k]; acc[r] += w * sv; } }
#pragma unroll
    for (int r = 0; r < 5; ++r) { LAS float* q = red + (kl * 5 + r) * 128 + c4 * 4; q[0] = acc[r][0]; q[1] = acc[r][1]; q[2] = acc[r][2]; q[3] = acc[r][3]; }
    __syncthreads();
    for (int o = tid; o < 640; o += NTHREADS) { const int r = o >> 7, cc = o & 127; float sum = 0.f;
#pragma unroll
        for (int k2 = 0; k2 < 16; ++k2) sum += red[(k2 * 5 + r) * 128 + cc];
        MODP[(size_t)((l * 4 + kq) * 5 + r) * 6144 + cgp * 128 + cc] = sum; }
    __syncthreads();
}

constexpr int N_GEMV = 384, N_TIN = 3584, N_TOUT = 1024, N_TPOOL = 32;
constexpr int IT_TIN = N_GEMV, IT_TOUT = IT_TIN + 2 * N_TIN, IT_TPOOL = IT_TOUT + 2 * N_TOUT, IT_ROPE = IT_TPOOL + N_TPOOL, N_ITEMS0 = IT_ROPE + 1;

__device__ __forceinline__ void phase0(const Params& p, LAS unsigned char* lds) {
    LAS float* fl = (LAS float*)lds;
    for (int it = blockIdx.x; it < N_ITEMS0; it += gridDim.x) {
        if (it < IT_TIN) gemv_item(p, it, fl);
        else if (it < IT_TOUT) { const int q = it - IT_TIN, l = q / N_TIN, t = q % N_TIN, tk = t / 112, tn = t % 112;
            transpose_tile(p.w_in + (size_t)l * DM * DIN, DM, DIN, (bf16_t*)(p.ws + OFF_WTIN) + (size_t)l * DIN * DM, tk * 64, tn * 64, (tn * 64 >= C_Q && tn * 64 < C_V), fl); }
        else if (it < IT_TPOOL) { const int q = it - IT_TOUT, l = q / N_TOUT, t = q % N_TOUT, tk = t / 32, tn = t % 32;
            transpose_tile(p.w_out + (size_t)l * DM * DM, DM, DM, (bf16_t*)(p.ws + OFF_WTOUT) + (size_t)l * DM * DM, tk * 64, tn * 64, false, fl); }
        else if (it < IT_ROPE) { const int q = it - IT_TPOOL, mtx = q >> 2, tk = (q >> 1) & 1, tn = q & 1;
            transpose_tile(p.pool_w + (size_t)mtx * 128 * 128, 128, 128, (bf16_t*)(p.ws + OFF_PWT) + (size_t)mtx * 128 * 128, tk * 64, tn * 64, false, fl); }
        else { float* rope = (float*)(p.ws + OFF_ROPE);
            for (int e = otid(); e < 1024; e += NTHREADS) { const int pos = e >> 4, i = e & 15;
                const float inv = exp2f(-(float)i * 0.830482023721841f);
                const float ang = (float)pos * inv; float sn, cs; sincosf(ang, &sn, &cs);
                rope[2 * e] = cs; rope[2 * e + 1] = sn; } }
    }
}

__device__ __forceinline__ void phase_mod0(const Params& p) {
    const int tid = otid(), G = gridDim.x, blk = blockIdx.x;
    const float* MODP = (const float*)(p.ws + OFF_MODP); float* MODF = (float*)(p.ws + OFF_MODF);
    bf16_t* H = (bf16_t*)(p.ws + OFF_HY);
    for (int idx = blk * NTHREADS + tid; idx < 2 * 5 * 6144; idx += G * NTHREADS) {
        const int l = idx / 30720, rem = idx % 30720, r = rem / 6144, n = rem % 6144; float v = p.b_mod[l * 6144 + n];
#pragma unroll
        for (int kq = 0; kq < 4; ++kq) v += MODP[(size_t)((l * 4 + kq) * 5 + r) * 6144 + n];
        MODF[idx] = v; }
    const int per = (MROWS + G - 1) / G; int r0 = blk * per, r1 = r0 + per; if (r1 > MROWS) r1 = MROWS;
    const int col = 4 * tid;
    while (r0 < r1) {
        const int b = r0 < NLAT ? r0 / SEQ : 4; int rend = r0 < NLAT ? (b + 1) * SEQ : MROWS; if (rend > r1) rend = r1;
        f32x4 sh = *(const f32x4*)(p.b_mod + col), sc = *(const f32x4*)(p.b_mod + 2048 + col);
#pragma unroll
        for (int kq = 0; kq < 4; ++kq) { sh += *(const f32x4*)(MODP + (size_t)(kq * 5 + b) * 6144 + col); sc += *(const f32x4*)(MODP + (size_t)(kq * 5 + b) * 6144 + 2048 + col); }
        sc += 1.f;
#pragma unroll 4
        for (int row = r0; row < rend; ++row) {
            const float* src = row < NLAT ? p.x + (size_t)row * DM : p.ctx + (size_t)(row - NLAT) * DM;
            const f32x4 v = *(const f32x4*)(src + col); const f32x4 h = v * sc + sh;
            u32x2 w; w.x = pk2(h[0], h[1]); w.y = pk2(h[2], h[3]); *(u32x2*)(H + (size_t)row * DM + col) = w; }
        r0 = rend;
    }
}

struct OrderX {
    pg8::StaticOrder base; int nextra, epm0, epn0, epnn;
    __device__ __forceinline__ bool next(int i, pg8::Unit& u) const {
        const long L = (long)i * base.G + base.c; if (L < base.nwg) return base.next(i, u);
        const int e = (int)(L - base.nwg); if (e >= nextra) return false; u.pm = epm0 + e / epnn; u.pn = epn0 + e % epnn; return true; }
    __device__ __forceinline__ void a_ready(const pg8::Unit&) const {}
    __device__ __forceinline__ void done(const pg8::Unit&) const {}
};

struct EpiIn {
    static constexpr bool PERM = true, AFTER_DRAIN = false;
    bf16_t* P; const float* rope;
    __device__ __forceinline__ void operator()(const f32x4 (&acc)[2][2][4][2], const pg8::Unit& u, int wr, int wc, int fr, int fq) const {
        const bool isq = (u.pn >= 8 && u.pn < 12), isk = (u.pn >= 12 && u.pn < 16);
        const bool dorope = (isq || isk) && (u.pm < 64);
        const float qs = isq ? QSCALE : 1.f;
#pragma unroll
        for (int ai = 0; ai < 2; ++ai)
#pragma unroll
            for (int m = 0; m < 4; ++m) {
                const int row = u.pm * 256 + ai * 128 + wr * 64 + m * 16 + fr; const int t = row & 4095, prow = t >> 6, pcol = t & 63;
#pragma unroll
                for (int bj = 0; bj < 2; ++bj) {
                    const int col0 = u.pn * 256 + bj * 128 + wc * 32 + 8 * fq;
                    f32x4 v0 = acc[ai][bj][m][0], v1 = acc[ai][bj][m][1];
                    if (dorope) { const int part = (col0 >> 5) & 1, i0 = (col0 & 31) >> 1, pos = part ? pcol : prow; const float* rp = rope + (pos * 16 + i0) * 2;
                        const f32x4 c0 = *(const f32x4*)rp, c1 = *(const f32x4*)(rp + 4); float a, b;
                        a = v0[0]; b = v0[1]; v0[0] = a * c0[0] - b * c0[1]; v0[1] = a * c0[1] + b * c0[0];
                        a = v0[2]; b = v0[3]; v0[2] = a * c0[2] - b * c0[3]; v0[3] = a * c0[3] + b * c0[2];
                        a = v1[0]; b = v1[1]; v1[0] = a * c1[0] - b * c1[1]; v1[1] = a * c1[1] + b * c1[0];
                        a = v1[2]; b = v1[3]; v1[2] = a * c1[2] - b * c1[3]; v1[3] = a * c1[3] + b * c1[2]; }
                    v0 = v0 * qs; v1 = v1 * qs;
                    u32x4 w; w.x = pk2(v0[0], v0[1]); w.y = pk2(v0[2], v0[3]); w.z = pk2(v1[0], v1[1]); w.w = pk2(v1[2], v1[3]);
                    *(u32x4*)(P + (size_t)row * DIN + col0) = w; } }
    }
};

struct EpiOut {
    static constexpr bool PERM = true, AFTER_DRAIN = false;
    const float* xlat; const float* xctx; float* olat; float* octx; const float* gate;
    __device__ __forceinline__ void operator()(const f32x4 (&acc)[2][2][4][2], const pg8::Unit& u, int wr, int wc, int fr, int fq) const {
        const bool lat = u.pm < 64;
#pragma unroll
        for (int ai = 0; ai < 2; ++ai)
#pragma unroll
            for (int m = 0; m < 4; ++m) {
                const int row = u.pm * 256 + ai * 128 + wr * 64 + m * 16 + fr; const int b = lat ? (row >> 12) : 4;
                const float* xr = lat ? xlat + (size_t)row * DM : xctx + (size_t)(row - NLAT) * DM;
                float* orow = lat ? olat + (size_t)row * DM : octx + (size_t)(row - NLAT) * DM;
                const float* gr = gate + b * 6144;
#pragma unroll
                for (int bj = 0; bj < 2; ++bj) {
                    const int col0 = u.pn * 256 + bj * 128 + wc * 32 + 8 * fq;
                    const f32x4 g0 = *(const f32x4*)(gr + col0), g1 = *(const f32x4*)(gr + col0 + 4);
                    const f32x4 x0 = *(const f32x4*)(xr + col0), x1 = *(const f32x4*)(xr + col0 + 4);
                    const f32x4 z0 = x0 * ALPHA + g0 * acc[ai][bj][m][0], z1 = x1 * ALPHA + g1 * acc[ai][bj][m][1];
                    *(f32x4*)(orow + col0) = z0; *(f32x4*)(orow + col0 + 4) = z1; } }
    }
};

namespace att {
constexpr int SHM_V = 16384, SHM_K = 8192, NSLOT = 3;
constexpr int LDS_K = 0, LDS_V = NSLOT * SHM_K, LDS_WS = LDS_V + NSLOT * SHM_V, LDS_TOTAL = LDS_WS + 8 * 64 * 4;
constexpr float THRL = 8.f;
#define KSW(row, chunk) ((row) * 128 + ((((chunk) ^ (((row) >> 1) & 7))) << 4))
#define SBAR() __builtin_amdgcn_sched_barrier(0)
__device__ __forceinline__ int crow(int r, int hi) { return (r & 3) + 8 * (r >> 2) + 4 * hi; }
__device__ __forceinline__ unsigned cvtpk(float lo, float hi) { unsigned r; asm volatile("v_cvt_pk_bf16_f32 %0, %1, %2" : "=v"(r) : "v"(lo), "v"(hi)); return r; }

__device__ __forceinline__ float max3f(float a, float b, float c) { float r; asm("v_max3_f32 %0, %1, %2, %3" : "=v"(r) : "v"(a), "v"(b), "v"(c)); return r; }
template <bool FIRST, int VAR = 0>
__device__ __forceinline__ void partialSM(f32x16& p0, f32x16& p1, float& mref) {
    if (FIRST) {
        float pmax = max3f(p0[0], p0[1], p1[0]); pmax = max3f(pmax, p1[1], p0[2]);
#pragma unroll
        for (int r = 2; r < 16; r += 2) { pmax = max3f(pmax, p1[r], p1[r + 1]); if (r + 2 < 16) pmax = max3f(pmax, p0[r + 1], p0[r + 2]); else pmax = fmaxf(pmax, p0[r + 1]); }
        { auto rr = __builtin_amdgcn_permlane32_swap(__float_as_uint(pmax), __float_as_uint(pmax), false, false);
          pmax = fmaxf(__uint_as_float(rr[0]), __uint_as_float(rr[1])); }
        mref = pmax;
    }
    const float mn = mref;
#pragma unroll
    for (int r = 0; r < 16; ++r) p0[r] = (VAR & 1) ? (p0[r] - mn) * 0.001f : __builtin_amdgcn_exp2f(p0[r] - mn);
}
template <int VAR = 0>
__device__ __forceinline__ float finishSM(f32x16& p0, f32x16& p1, float& mref, float& l_reg, bf16x8& pa0, bf16x8& pa1, bf16x8& pa2, bf16x8& pa3) {
    const float mn = mref;
#pragma unroll
    for (int r = 0; r < 16; ++r) p1[r] = (VAR & 1) ? (p1[r] - mn) * 0.001f : __builtin_amdgcn_exp2f(p1[r] - mn);
    float ps = 0;
#pragma unroll
    for (int r = 0; r < 16; ++r) ps += p0[r];
#pragma unroll
    for (int r = 0; r < 16; ++r) ps += p1[r];
    { auto rr = __builtin_amdgcn_permlane32_swap(__float_as_uint(ps), __float_as_uint(ps), false, false);
      ps = __uint_as_float(rr[0]) + __uint_as_float(rr[1]); }
    float f = 1.f;
    if (__builtin_expect(__any(ps > 16777216.f), 0)) {
        if (ps > 16777216.f) { const int e = ((__float_as_uint(ps) >> 23) & 0xff) - 127; f = __uint_as_float((unsigned)(127 - e) << 23); mref += (float)e; }
#pragma unroll
        for (int r = 0; r < 16; ++r) { p0[r] *= f; p1[r] *= f; }
        ps *= f; l_reg *= f;
    }
    l_reg += ps;
#define PK4(P, BASE, OUT) do { unsigned a0 = cvtpk(P[BASE + 0], P[BASE + 1]), a1 = cvtpk(P[BASE + 2], P[BASE + 3]);   \
    unsigned b0 = cvtpk(P[BASE + 4], P[BASE + 5]), b1 = cvtpk(P[BASE + 6], P[BASE + 7]);                              \
    auto r0 = __builtin_amdgcn_permlane32_swap(a0, b0, false, false); auto r1 = __builtin_amdgcn_permlane32_swap(a1, b1, false, false); \
    u32x4 w = {r0[0], r1[0], r0[1], r1[1]}; OUT = *reinterpret_cast<bf16x8*>(&w); } while (0)
    PK4(p0, 0, pa0); PK4(p0, 8, pa1); PK4(p1, 0, pa2); PK4(p1, 8, pa3);
#undef PK4
    return f;
}
__device__ __forceinline__ void qkt(f32x16& p0, f32x16& p1, const LAS char* Ks, const bf16x8* qr, int r32, int hi) {
#pragma unroll
    for (int d0 = 0; d0 < 4; ++d0) { const int ch = d0 * 2 + hi;
        bf16x8 b0 = *(const LAS bf16x8*)(Ks + KSW(r32, ch));
        bf16x8 b1 = *(const LAS bf16x8*)(Ks + KSW(32 + r32, ch));
        if (d0 == 0) { p0 = __builtin_amdgcn_mfma_f32_32x32x16_bf16(b0, qr[0], f32x16{}, 0, 0, 0); p1 = __builtin_amdgcn_mfma_f32_32x32x16_bf16(b1, qr[0], f32x16{}, 0, 0, 0); }
        else { p0 = __builtin_amdgcn_mfma_f32_32x32x16_bf16(b0, qr[d0], p0, 0, 0, 0); p1 = __builtin_amdgcn_mfma_f32_32x32x16_bf16(b1, qr[d0], p1, 0, 0, 0); } }
}
__device__ __forceinline__ int v_st(int k, int c) { const int kk = (k & ~0xC) | ((k & 4) << 1) | ((k & 8) >> 1); return ((kk >> 3) * 4 + (c >> 5)) * 512 + ((kk & 7) * 32 + (c & 31)) * 2; }
__device__ __forceinline__ int v_rd_base(int lane) { return ((lane & 3) << 3) | (((lane >> 2) & 3) << 6) | (((lane >> 4) & 1) << 5) | (((lane >> 5) & 1) << 8); }
constexpr int v_rd_off(int d0, int ks, int half) { return d0 * 512 + ks * 4096 + half * 2048; }
template <int OFF> __device__ __forceinline__ s16x4 tr_read(int vb) {
    s16x4 r; asm volatile("ds_read_b64_tr_b16 %0, %1 offset:%2" : "=&v"(r) : "v"(vb), "i"(OFF) : "memory"); return r;
}
#define RD8(D0, X) const s16x4 X##0 = tr_read<v_rd_off(D0, 0, 0)>(vb), X##1 = tr_read<v_rd_off(D0, 0, 1)>(vb), X##2 = tr_read<v_rd_off(D0, 1, 0)>(vb), X##3 = tr_read<v_rd_off(D0, 1, 1)>(vb), \
    X##4 = tr_read<v_rd_off(D0, 2, 0)>(vb), X##5 = tr_read<v_rd_off(D0, 2, 1)>(vb), X##6 = tr_read<v_rd_off(D0, 3, 0)>(vb), X##7 = tr_read<v_rd_off(D0, 3, 1)>(vb)
#define WDEP(N, X) s16x4 X##w0 = X##0, X##w1 = X##1, X##w2 = X##2, X##w3 = X##3, X##w4 = X##4, X##w5 = X##5, X##w6 = X##6, X##w7 = X##7; \
    asm volatile("s_waitcnt lgkmcnt(" #N ")" : "+v"(X##w0), "+v"(X##w1), "+v"(X##w2), "+v"(X##w3), "+v"(X##w4), "+v"(X##w5), "+v"(X##w6), "+v"(X##w7) :: "memory")
#define PKV(L, H) (bf16x8){L[0], L[1], L[2], L[3], H[0], H[1], H[2], H[3]}
#define MM4(od, X) od = __builtin_amdgcn_mfma_f32_32x32x16_bf16(pa0, PKV(X##w0, X##w1), od, 0, 0, 0); od = __builtin_amdgcn_mfma_f32_32x32x16_bf16(pa1, PKV(X##w2, X##w3), od, 0, 0, 0); \
    od = __builtin_amdgcn_mfma_f32_32x32x16_bf16(pa2, PKV(X##w4, X##w5), od, 0, 0, 0); od = __builtin_amdgcn_mfma_f32_32x32x16_bf16(pa3, PKV(X##w6, X##w7), od, 0, 0, 0)
__device__ __forceinline__ void pv_d0(f32x16* o, int vb, bf16x8 pa0, bf16x8 pa1, bf16x8 pa2, bf16x8 pa3) {
    RD8(0, a);
    RD8(1, b); WDEP(8, a); MM4(o[0], a);
    RD8(2, c); WDEP(8, b); MM4(o[1], b);
    RD8(3, d); WDEP(8, c); MM4(o[2], c);
    WDEP(0, d); MM4(o[3], d);
}
#undef RD8
#undef WDEP
#undef PKV
#undef MM4

template <int VAR>
__device__ __forceinline__ void attn_map(const bf16_t* __restrict__ Qw, const bf16_t* __restrict__ Kc, const bf16_t* __restrict__ Vc, int ctx_row0, int lat_row0, int nct, int NT,
                                         LAS char* lds, f32x16 (&o)[4], float& l_out) {
    const int tid = otid(), wid = __builtin_amdgcn_readfirstlane(tid >> 6), lane = tid & 63, r32 = lane & 31, hi = lane >> 5;
    LAS char* V_lds = lds + LDS_V; LAS char* K_lds = lds + LDS_K;
    LAS float* ws = (LAS float*)(lds + LDS_WS) + wid * 64; LAS float* al_l = ws + 32;
    float m_reg = 0.f, l_reg = 0;
#pragma unroll
    for (int d = 0; d < 4; ++d) o[d] = f32x16{};
    const int krow = wid * 8 + (lane >> 3), kchunk = (lane & 7) ^ ((krow >> 1) & 7);
    const bf16_t* ksrc = Kc + (size_t)krow * DIN + kchunk * 8;
    const int kk = wid * 8 + ((lane & 31) >> 2), kkey = (kk & ~0xC) | ((kk & 4) << 1) | ((kk & 8) >> 1);
    const bf16_t* vsrc0 = Vc + (size_t)kkey * DIN + hi * 32 + (lane & 3) * 8;
    const int vb0 = (int)(uintptr_t)V_lds + v_rd_base(lane);
#define KROW(t) (((t) < nct) ? (ctx_row0 + (t) * 64) : (lat_row0 + ((t) - nct) * 64))
#define DMA(t, slot) do { const size_t ro_ = (size_t)KROW(t) * DIN; \
    __builtin_amdgcn_global_load_lds((const unsigned*)(ksrc + ro_), (LAS unsigned*)(K_lds + (slot) * SHM_K + wid * 1024), 16, 0, 0); \
    __builtin_amdgcn_global_load_lds((const unsigned*)(vsrc0 + ro_), (LAS unsigned*)(V_lds + (slot) * SHM_V + wid * 2048), 16, 0, 0); \
    __builtin_amdgcn_global_load_lds((const unsigned*)(vsrc0 + ro_ + 64), (LAS unsigned*)(V_lds + (slot) * SHM_V + wid * 2048 + 1024), 16, 0, 0); } while (0)
#define WAIT_BAR(N) asm volatile("s_waitcnt vmcnt(" #N ") lgkmcnt(0)\n\ts_barrier" ::: "memory")
#define RESC(a) do { if (__any((a) < 1.f)) { if (hi == 0) al_l[r32] = (a); asm volatile("s_waitcnt lgkmcnt(0)" ::: "memory"); \
    _Pragma("unroll") for (int d = 0; d < 4; ++d) _Pragma("unroll") for (int r = 0; r < 16; ++r) o[d][r] *= al_l[crow(r, hi)]; } } while (0)
#define STEP(C0, C1, alC, P0, P1, alP, t, GD) do { WAIT_BAR(0); \
    if (GD && !(VAR & 2)) { DMA((t) + 1, sn); } SBAR(); \
    qkt(C0, C1, K_lds + sc_ * SHM_K, qr, r32, hi); \
    { const float f_ = finishSM<VAR>(P0, P1, m_reg, l_reg, pa0, pa1, pa2, pa3); RESC(f_); } SBAR(); \
    if (!(VAR & 4)) pv_d0(o, vb0 + sp * SHM_V, pa0, pa1, pa2, pa3); partialSM<false, VAR>(C0, C1, m_reg); \
    sp = sc_; sc_ = sn; sn = (sn == NSLOT - 1) ? 0 : sn + 1; } while (0)
    f32x16 pA0, pA1, pB0, pB1; const float alA = 1.f, alB = 1.f; bf16x8 pa0, pa1, pa2, pa3; (void)alA; (void)alB;
    WAIT_BAR(0);
    bf16x8 qr[4];
#pragma unroll
    for (int d0 = 0; d0 < 4; ++d0) qr[d0] = *reinterpret_cast<const bf16x8*>(Qw + d0 * 16);
    if (!(VAR & 2)) { DMA(0, 0); DMA(1, 1); }
    WAIT_BAR(3);
    qkt(pA0, pA1, K_lds, qr, r32, hi); partialSM<true, VAR>(pA0, pA1, m_reg);
    int sp = 0, sc_ = 1, sn = 2;
    for (int j = 1; j + 1 < NT; j += 2) {
        STEP(pB0, pB1, alB, pA0, pA1, alA, j, true);
        STEP(pA0, pA1, alA, pB0, pB1, alB, j + 1, true);
    }
    STEP(pB0, pB1, alB, pA0, pA1, alA, NT - 1, false);
    { const float f_ = finishSM<VAR>(pB0, pB1, m_reg, l_reg, pa0, pa1, pa2, pa3); RESC(f_); } SBAR();
    pv_d0(o, vb0 + sp * SHM_V, pa0, pa1, pa2, pa3);
    l_out = l_reg;
#undef KROW
#undef DMA
#undef WAIT_BAR
#undef RESC
#undef STEP
}

constexpr int LDS_OB = 0, LDS_OA = 81920, LDS_ATT_END = LDS_OA + 65536;
static_assert(LDS_TOTAL <= LDS_OA, "attention LDS map");
template <int VAR = 0>
__device__ __forceinline__ void attn_unit(const Params& p, int l, int h, int qrow0, int ctx_row0, int lat_row0, int nct, int NT, float lam, float oml, LAS char* lds, bf16_t* Y) {
    const int tid = otid(), wid = tid >> 6, lane = tid & 63, r32 = lane & 31, hi = lane >> 5;
    const bf16_t* P = (const bf16_t*)(p.ws + OFF_P);
    LAS float* li_l = (LAS float*)(lds + LDS_WS) + wid * 64;
    f32x16 o[4]; float l_reg;
#ifndef MPN
#define MPN 2
#endif
#pragma unroll
    for (int mp = 0; mp < MPN; ++mp) {
        const bf16_t* Qw = P + (size_t)(qrow0 + wid * 32 + r32) * DIN + C_Q + h * 128 + mp * 64 + hi * 8;
        attn_map<VAR>(Qw, P + C_K + h * 128 + mp * 64, P + C_V + h * 128, ctx_row0, lat_row0, nct, NT, lds, o, l_reg);
        if (hi == 0) li_l[r32] = l_reg; asm volatile("s_waitcnt lgkmcnt(0)" ::: "memory");
        float rli[16];
#pragma unroll
        for (int r = 0; r < 16; ++r) rli[r] = __builtin_amdgcn_rcpf(li_l[crow(r, hi)]);
        if (mp == 1) __syncthreads();
        LAS bf16_t* ol = (LAS bf16_t*)(lds + (mp == 0 ? LDS_OA : LDS_OB)) + (wid * 32 + 4 * hi) * 128 + r32;
#pragma unroll
        for (int r = 0; r < 16; ++r)
#pragma unroll
            for (int d0 = 0; d0 < 4; ++d0) ol[((r & 3) + 8 * (r >> 2)) * 128 + d0 * 32] = (bf16_t)(cvtpk(o[d0][r] * rli[r], 0.f) & 0xffffu);
        if (mp == 1) {
            asm volatile("s_waitcnt lgkmcnt(0)" ::: "memory");
            int c4 = r32 * 4; asm volatile("" : "+v"(c4));
            const f32x4 g4 = *(const f32x4*)(p.subln_g + l * 128 + c4) * oml;
            const LAS bf16_t* A = (const LAS bf16_t*)(lds + LDS_OA) + (wid * 32 + hi) * 128 + c4;
            const LAS bf16_t* B = (const LAS bf16_t*)(lds + LDS_OB) + (wid * 32 + hi) * 128 + c4;
            const bf16_t* agp = P + (size_t)(qrow0 + wid * 32 + hi) * DIN + C_AG + h * 128 + c4;
            bf16_t* yp = Y + (size_t)(qrow0 + wid * 32 + hi) * DM + 512 + h * 128 + c4;
#pragma unroll 2
            for (int st = 0; st < 16; ++st) {
                const u32x2 av = *(const LAS u32x2*)(A + st * 256), bv = *(const LAS u32x2*)(B + st * 256);
                const u32x2 ag = *(const u32x2*)(agp + (size_t)(st * 2) * DIN);
                const float f0 = bflo(av.x) - lam * bflo(bv.x), f1 = bfhi(av.x) - lam * bfhi(bv.x), f2 = bflo(av.y) - lam * bflo(bv.y), f3 = bfhi(av.y) - lam * bfhi(bv.y);
                float ss = (f0 * f0 + f1 * f1) + (f2 * f2 + f3 * f3);
#pragma unroll
                for (int off = 1; off < 32; off <<= 1) ss += __shfl_xor(ss, off);
                const float rstd = __builtin_amdgcn_rsqf(ss * (1.f / 128.f) + RMS_EPS);
                const float y0 = f0 * rstd * g4[0] * silu_f(bflo(ag.x)), y1 = f1 * rstd * g4[1] * silu_f(bfhi(ag.x));
                const float y2 = f2 * rstd * g4[2] * silu_f(bflo(ag.y)), y3 = f3 * rstd * g4[3] * silu_f(bfhi(ag.y));
                u32x2 w; w.x = cvtpk(y0, y1); w.y = cvtpk(y2, y3);
                *(u32x2*)(yp + (size_t)(st * 2) * DM) = w;
            }
        }
    }
}
#undef KSW
#undef SBAR
}

__device__ __forceinline__ void seq_bounds(int R0, int& s0, int& s1) { if (R0 < NLAT) { s0 = R0 & ~(SEQ - 1); s1 = s0 + SEQ; } else { s0 = NLAT + ((R0 - NLAT) & ~(CTXL - 1)); s1 = s0 + CTXL; } }

__device__ __forceinline__ void unpack8(const u32x4 w, float (&f)[8]) { f[0] = bflo(w.x); f[1] = bfhi(w.x); f[2] = bflo(w.y); f[3] = bfhi(w.y); f[4] = bflo(w.z); f[5] = bfhi(w.z); f[6] = bflo(w.w); f[7] = bfhi(w.w); }

__device__ __forceinline__ void conv_item(const Params& p, int l, int rt) {
    const int tid = otid(), ch0 = (tid & 63) * 8, R0 = rt * 64, r0 = R0 + (tid >> 6) * 8; int s0, s1; seq_bounds(R0, s0, s1);
    const bf16_t* P = (const bf16_t*)(p.ws + OFF_P); bf16_t* Y = (bf16_t*)(p.ws + OFF_HY);
    const float* cw = p.conv_w + l * 3 * 512 + ch0;
    float w0[8], w1[8], w2[8];
#pragma unroll
    for (int j = 0; j < 8; ++j) { w0[j] = cw[j]; w1[j] = cw[512 + j]; w2[j] = cw[1024 + j]; }
#define LD16(row, sect) (*(const u32x4*)(P + (size_t)(row) * DIN + (sect) * 512 + ch0))
    float vp[8], vc[8], vn[8], a[8], b[8];
#pragma unroll
    for (int j = 0; j < 8; ++j) vp[j] = 0.f;
    if (r0 - 1 >= s0) { unpack8(LD16(r0 - 1, 0), a); unpack8(LD16(r0 - 1, 2), b);
#pragma unroll
        for (int j = 0; j < 8; ++j) vp[j] = a[j] * b[j]; }
    { unpack8(LD16(r0, 0), a); unpack8(LD16(r0, 2), b);
#pragma unroll
      for (int j = 0; j < 8; ++j) vc[j] = a[j] * b[j]; }
#pragma unroll 2
    for (int i = 0; i < 8; ++i) { const int row = r0 + i;
#pragma unroll
        for (int j = 0; j < 8; ++j) vn[j] = 0.f;
        if (row + 1 < s1) { unpack8(LD16(row + 1, 0), a); unpack8(LD16(row + 1, 2), b);
#pragma unroll
            for (int j = 0; j < 8; ++j) vn[j] = a[j] * b[j]; }
        unpack8(LD16(row, 1), a); unpack8(LD16(row, 3), b);
        float y[8];
#pragma unroll
        for (int j = 0; j < 8; ++j) y[j] = silu_f(b[j]) * a[j] * (w0[j] * vp[j] + w1[j] * vc[j] + w2[j] * vn[j]);
        u32x4 w; w.x = pk2(y[0], y[1]); w.y = pk2(y[2], y[3]); w.z = pk2(y[4], y[5]); w.w = pk2(y[6], y[7]);
        *(u32x4*)(Y + (size_t)row * DM + ch0) = w;
#pragma unroll
        for (int j = 0; j < 8; ++j) { vp[j] = vc[j]; vc[j] = vn[j]; } }
#undef LD16
}

__device__ __forceinline__ void pool_item(const Params& p, int l, int rt, int g, LAS unsigned char* lds) {
    const int tid = otid(), R0 = rt * 64; int s0, s1; seq_bounds(R0, s0, s1);
    const bf16_t* P = (const bf16_t*)(p.ws + OFF_P); bf16_t* Y = (bf16_t*)(p.ws + OFF_HY);
    LAS bf16_t* ut = (LAS bf16_t*)lds;
    LAS bf16_t* dt = ut + 80 * 136;
    for (int c = tid; c < 1280; c += NTHREADS) { const int row = c >> 4, ch = c & 15, grow = R0 - 8 + row;
        u32x4 v = (u32x4){0u, 0u, 0u, 0u}; if (grow >= s0 && grow < s1) v = *(const u32x4*)(P + (size_t)grow * DIN + C_PU + g * 128 + ch * 8);
        *(LAS u32x4*)(ut + row * 136 + ch * 8) = v; }
    __syncthreads();
    { const int cp = tid & 63, rg = tid >> 6, hw = 1 << g, t0 = R0 + rg * 8;
#define LDU(lrow) (*(const LAS unsigned*)(ut + (lrow) * 136 + 2 * cp))
      float a0 = 0.f, a1 = 0.f;
      for (int j = -hw; j < hw; ++j) { const unsigned u = LDU(rg * 8 + 8 + j); a0 += bflo(u); a1 += bfhi(u); }
#pragma unroll
      for (int i = 0; i < 8; ++i) { const int t = t0 + i, lr = rg * 8 + 8 + i; const int lo_t = (t - hw < s0) ? s0 : t - hw, hi_t = (t + hw > s1) ? s1 : t + hw;
          const float inv = 1.f / (float)(hi_t - lo_t); const unsigned u = LDU(lr);
          *(LAS unsigned*)(dt + (rg * 8 + i) * 136 + 2 * cp) = pk2(a0 * inv - bflo(u), a1 * inv - bfhi(u));
          const unsigned un = LDU(lr + hw), uo = LDU(lr - hw);
          a0 += bflo(un) - bflo(uo); a1 += bfhi(un) - bfhi(uo); }
#undef LDU
    }
    __syncthreads();
    { const int wid = tid >> 6, lane = tid & 63, mt = wid & 3, nh = wid >> 2, fr = lane & 15, fq = lane >> 4;
      const bf16_t* PWT = (const bf16_t*)(p.ws + OFF_PWT) + (size_t)(l * 4 + g) * 128 * 128;
      f32x4 acc[4];
#pragma unroll
      for (int n = 0; n < 4; ++n) acc[n] = (f32x4){0.f, 0.f, 0.f, 0.f};
#pragma unroll
      for (int ks = 0; ks < 4; ++ks) { const bf16x8 a = *(const LAS bf16x8*)(dt + (mt * 16 + fr) * 136 + ks * 32 + fq * 8);
#pragma unroll
          for (int n = 0; n < 4; ++n) { const bf16x8 b = *(const bf16x8*)(PWT + (size_t)(nh * 64 + n * 16 + fr) * 128 + ks * 32 + fq * 8);
              acc[n] = __builtin_amdgcn_mfma_f32_16x16x32_bf16(a, b, acc[n], 0, 0, 0); } }
#pragma unroll
      for (int n = 0; n < 4; ++n)
#pragma unroll
          for (int j = 0; j < 4; ++j) { const int row = R0 + mt * 16 + 4 * fq + j, col = g * 128 + nh * 64 + n * 16 + fr;
              const float pg = bf2f(P[(size_t)row * DIN + C_PG + col]);
              const float y = silu_f(pg) * p.pool_scale[l * 512 + col] * acc[n][j];
              Y[(size_t)row * DM + 1536 + col] = (bf16_t)(pk2(y, 0.f) & 0xffffu); } }
    __syncthreads();
}

__device__ __forceinline__ void phase_mix(const Params& p, int l, LAS unsigned char* lds) {
    const int G = gridDim.x, blk = blockIdx.x, lane = otid() & 63;
    const float lam_init = (l == 0) ? 0.2f : 0.35550906759096935f;
    float lam;
    { const float a = p.lq1[l * 64 + lane] * p.lk1[l * 64 + lane], b = p.lq2[l * 64 + lane] * p.lk2[l * 64 + lane];
      lam = __expf(wave_sum(a)) - __expf(wave_sum(b)) + lam_init; }
    const int nrt = (l == 0) ? MROWS / 64 : NLAT / 64;
    const int n_conv = nrt, n_pool = nrt * 4, n_cattn = (l == 0) ? 32 : 0;
#ifndef NO_CONV
    for (int it = blk; it < n_conv; it += G) conv_item(p, l, it);
#endif
#ifndef NO_POOL
    for (int it = blk; it < n_pool; it += G) pool_item(p, l, it >> 2, it & 3, lds);
#endif
#ifdef PROBE_CP2
    for (int it = blk; it < n_conv; it += G) conv_item(p, l, it);
    for (int it = blk; it < n_pool; it += G) pool_item(p, l, it >> 2, it & 3, lds);
#endif
#ifndef NO_LATTN
    for (int u = blk; u < 512 + n_cattn; u += G) {
        int h, qrow0, crow0, lrow0, NT;
        if (u < 512) {
            int bh, qb;
            if (G == 256) { const int i = u >> 8, xcd = blk & 7, j = blk >> 3; bh = xcd * 4 + i * 2 + (j >> 4); qb = j & 15; }
            else { bh = u >> 4; qb = u & 15; }
            const int b = bh >> 3; h = bh & 7; qrow0 = b * SEQ + qb * 256; crow0 = NLAT + b * CTXL; lrow0 = b * SEQ; NT = 68;
        } else { const int q = u - 512, b = q >> 3; h = q & 7; qrow0 = NLAT + b * CTXL; crow0 = qrow0; lrow0 = qrow0; NT = 4; }
        att::attn_unit<0>(p, l, h, qrow0, crow0, lrow0, 4, NT, lam, 1.f - lam_init, (LAS char*)lds, (bf16_t*)(p.ws + OFF_HY));
    }
#endif
#ifdef PROBE_ATT
    if (l == 0) for (int u = blk; u < 512; u += G) {
        int bh, qb; if (G == 256) { const int i = u >> 8, xcd = blk & 7, j = blk >> 3; bh = xcd * 4 + i * 2 + (j >> 4); qb = j & 15; } else { bh = u >> 4; qb = u & 15; }
        const int b = bh >> 3, h = bh & 7;
        att::attn_unit<PROBE_ATT - 1>(p, l, h, b * SEQ + qb * 256, NLAT + b * CTXL, b * SEQ, 4, 68, lam, 1.f - lam_init, (LAS char*)lds, (bf16_t*)(p.ws + WS_END));
    }
#endif
    __syncthreads();
}

__device__ __forceinline__ void phase_ln(const Params& p, int l, bool final) {
    const int G = gridDim.x, tid = otid(), wid = tid >> 6, lane = tid & 63;
    const int nrows = final ? NLAT : MROWS;
    const float* MODF = (const float*)(p.ws + OFF_MODF); bf16_t* H = (bf16_t*)(p.ws + OFF_HY);
    const float* lg = p.ln_g + l * DM; const float* lb = p.ln_b + l * DM;
    for (int row = blockIdx.x * 8 + wid; row < nrows; row += G * 8) {
        const bool lat = row < NLAT;
        float* src = lat ? p.out + (size_t)row * DM : (float*)(p.ws + OFF_ZC) + (size_t)(row - NLAT) * DM;
        f32x4 v[8]; float s = 0.f;
#pragma unroll
        for (int i = 0; i < 8; ++i) { v[i] = *(const f32x4*)(src + (i * 64 + lane) * 4); s += (v[i][0] + v[i][1]) + (v[i][2] + v[i][3]); }
        const float mean = wave_sum(s) * (1.f / DM); float q = 0.f;
#pragma unroll
        for (int i = 0; i < 8; ++i) { const f32x4 d = v[i] - mean; q += (d[0] * d[0] + d[1] * d[1]) + (d[2] * d[2] + d[3] * d[3]); }
        const float rstd = __builtin_amdgcn_rsqf(wave_sum(q) * (1.f / DM) + LN_EPS);
        const int b = lat ? (row >> 12) : 4;
#pragma unroll
        for (int i = 0; i < 8; ++i) { const int col = (i * 64 + lane) * 4;
            const f32x4 xn = (v[i] - mean) * rstd * *(const f32x4*)(lg + col) + *(const f32x4*)(lb + col);
            if (lat) *(f32x4*)(src + col) = xn;
            if (!final) { const f32x4 sh = *(const f32x4*)(MODF + (size_t)(5 + b) * 6144 + col), sc = *(const f32x4*)(MODF + (size_t)(5 + b) * 6144 + 2048 + col);
                const f32x4 h = xn * (sc + 1.f) + sh; u32x2 w; w.x = pk2(h[0], h[1]); w.y = pk2(h[2], h[3]); *(u32x2*)(H + (size_t)row * DM + col) = w; } }
    }
}

__global__ void __launch_bounds__(NTHREADS, 2) hybrid_fwd(Params p) {
    extern __shared__ __attribute__((aligned(16))) unsigned char lds_g[];
    LAS unsigned char* lds = (LAS unsigned char*)lds_g;
    cg::grid_group grid = cg::this_grid();
    const int G = gridDim.x;

#ifndef PH_MASK
#define PH_MASK 0xFF
#endif
    if constexpr (PH_MASK & 1) phase0(p, lds);
    grid.sync();
    if constexpr (PH_MASK & 2) phase_mod0(p);
    grid.sync();
#pragma unroll 1
    for (int l = 0; l < 2; ++l) {
        if constexpr (PH_MASK & 4) {
            pg8::Gemm g{(const bf16_t*)(p.ws + OFF_HY), (const bf16_t*)(p.ws + OFF_WTIN) + (size_t)l * DIN * DM, (l == 0) ? MROWS : NLAT, DIN, DM};
            OrderX S; S.base.init((l == 0) ? MROWS : NLAT, DIN, G, (int)blockIdx.x); S.nextra = (l == 0) ? 0 : 32; S.epm0 = 64; S.epn0 = 12; S.epnn = 8;
            EpiIn E{(bf16_t*)(p.ws + OFF_P), (const float*)(p.ws + OFF_ROPE)};
            pg8::gemm_phase<EpiIn, OrderX, true, true>(lds, g, S, E);
        }
        grid.sync();
        if constexpr (PH_MASK & 8) phase_mix(p, l, lds);
#ifdef PROBE_MIX2
        grid.sync(); phase_mix(p, l, lds);
#endif
        grid.sync();
        if constexpr (PH_MASK & 16) {
            pg8::Gemm g{(const bf16_t*)(p.ws + OFF_HY), (const bf16_t*)(p.ws + OFF_WTOUT) + (size_t)l * DM * DM, (l == 0) ? MROWS : NLAT, DM, DM};
            OrderX S; S.base.init((l == 0) ? MROWS : NLAT, DM, G, (int)blockIdx.x); S.nextra = 0; S.epm0 = 0; S.epn0 = 0; S.epnn = 1;
            EpiOut E{(l == 0) ? p.x : p.out, p.ctx, p.out, (float*)(p.ws + OFF_ZC), (const float*)(p.ws + OFF_MODF) + (size_t)l * 5 * 6144 + 4096};
            pg8::gemm_phase<EpiOut, OrderX, true, true>(lds, g, S, E);
        }
        grid.sync();
        if constexpr (PH_MASK & 32) phase_ln(p, l, l == 1);
        if (l == 0) grid.sync();
    }
}

extern "C" void kernel_launch(void* const* d_in, const int* in_sizes, int n_in, void* d_out, int out_size, void* d_ws, size_t ws_size, hipStream_t stream) {
    static int grid_blocks = 0;
    if (grid_blocks == 0) {
        if (n_in != 18 || in_sizes[0] != NLAT * DM || out_size != NLAT * DM || ws_size < WS_END) {
            fprintf(stderr, "kernel_launch: shape/workspace mismatch: n_in %d in0 %d out %d ws %zu (need %zu)\n", n_in, n_in > 0 ? in_sizes[0] : -1, out_size, ws_size, (size_t)WS_END); grid_blocks = -1; return; }
        int dev = 0, cus = 0, per_cu = 0;
        hipGetDevice(&dev); hipDeviceGetAttribute(&cus, hipDeviceAttributeMultiprocessorCount, dev);
        if (hipFuncSetAttribute((const void*)hybrid_fwd, hipFuncAttributeMaxDynamicSharedMemorySize, LDS_BYTES) != hipSuccess) { fprintf(stderr, "kernel_launch: hipFuncSetAttribute failed\n"); grid_blocks = -1; return; }
        if (hipOccupancyMaxActiveBlocksPerMultiprocessor(&per_cu, (const void*)hybrid_fwd, NTHREADS, LDS_BYTES) != hipSuccess || per_cu < 1) { fprintf(stderr, "kernel_launch: occupancy query gave %d\n", per_cu); per_cu = 1; }
        (void)hipGetLastError();
        grid_blocks = cus * 1;
        if (grid_blocks > 256) grid_blocks = 256;
    }
    if (grid_blocks < 0) return;
    Params p{};
    p.x = (const float*)d_in[0]; p.c = (const float*)d_in[1]; p.ctx = (const float*)d_in[2]; p.c_ctx = (const float*)d_in[3]; p.w_mod = (const float*)d_in[4]; p.b_mod = (const float*)d_in[5];
    p.w_in = (const float*)d_in[6]; p.conv_w = (const float*)d_in[7]; p.lq1 = (const float*)d_in[8]; p.lk1 = (const float*)d_in[9]; p.lq2 = (const float*)d_in[10]; p.lk2 = (const float*)d_in[11];
    p.subln_g = (const float*)d_in[12]; p.pool_w = (const float*)d_in[13]; p.pool_scale = (const float*)d_in[14]; p.w_out = (const float*)d_in[15]; p.ln_g = (const float*)d_in[16]; p.ln_b = (const float*)d_in[17];
    p.out = (float*)d_out; p.ws = (unsigned char*)d_ws;
    void* args[] = {&p};
    const hipError_t e = hipLaunchCooperativeKernel((const void*)hybrid_fwd, dim3(grid_blocks), dim3(NTHREADS), args, LDS_BYTES, stream);
    if (e != hipSuccess) fprintf(stderr, "kernel_launch: cooperative launch failed: %s (grid %d)\n", hipGetErrorString(e), grid_blocks);
}
```

```cpp
#include <hip/hip_runtime.h>
#include <hip/hip_cooperative_groups.h>
#include <cstdio>
#include <cstdint>
namespace cg = cooperative_groups;
__device__ __forceinline__ int otid() { int t = threadIdx.x; asm volatile("" : "+v"(t)); return t; }
namespace pg8 {
#define PG8_LAS __attribute__((address_space(3)))
typedef unsigned short bf16_t;
typedef short bf16x8 __attribute__((ext_vector_type(8)));
typedef float f32x4 __attribute__((ext_vector_type(4)));
typedef unsigned u32x4 __attribute__((ext_vector_type(4)));
constexpr int BM = 256, BK = 64, HALF = 128, HTB = HALF * BK * 2  , STAGE_BYTES = 8 * HTB, NXCD = 8, WGM = 8;

__host__ __device__ __forceinline__ int lds_byte(int r, int c) { const int st = (r >> 4) * 2 + (c >> 5), rr = r & 15, cc = c & 31, ob = rr * 64 + cc * 2; return st * 1024 + (ob ^ (((ob >> 9) & 1) << 5)); }
__host__ __device__ __forceinline__ void stage_rc(int b, int& R, int& C) { const int st = b / 1024, sb = b % 1024, swz = sb ^ (((sb >> 9) & 1) << 5); R = (st >> 1) * 16 + swz / 64; C = (st & 1) * 32 + (swz % 64) / 2; }
__host__ __device__ __forceinline__ int perm32(int rho) { const int n = rho >> 4, i = rho & 15; return 8 * (i >> 2) + 4 * n + (i & 3); }

struct Unit { int pm, pn; };
struct Gemm { const bf16_t* A; const bf16_t* Bt; int M, N, K; };

struct StaticOrder {
    int nM, nN, nwg, G, c;
    __host__ __device__ void init(int M, int N, int G_, int c_) { nM = M / BM; nN = N / BM; nwg = nM * nN; G = G_; c = c_; }
    __host__ __device__ bool next(int i, Unit& u) const {
        const long L = (long)i * G + c; if (L >= nwg) return false;
        int wgid = (int)L; { const int q = nwg / NXCD, r = nwg % NXCD, xcd = wgid % NXCD, off = wgid / NXCD; wgid = (xcd < r ? xcd * (q + 1) : r * (q + 1) + (xcd - r) * q) + off; }
        const int nig = WGM * nN, gid = wgid / nig, fm = gid * WGM, gsz = (nM - fm) < WGM ? (nM - fm) : WGM;
        u.pm = fm + ((wgid % nig) % gsz); u.pn = (wgid % nig) / gsz; return true;
    }
    __device__ __forceinline__ void a_ready(const Unit&) const {}
    __device__ __forceinline__ void done(const Unit&) const {}
};

__device__ __forceinline__ unsigned cvt_pk_bf16(float lo, float hi) { unsigned r; asm volatile("v_cvt_pk_bf16_f32 %0, %1, %2" : "=v"(r) : "v"(lo), "v"(hi)); return r; }

template <class Epi, class Sched, bool ALIGN_EPI = false, bool SP2 = false>
__device__ __forceinline__ void gemm_phase(PG8_LAS unsigned char* lds, const Gemm g, const Sched& S, const Epi& E) {
    const int tid = otid(), wid = __builtin_amdgcn_readfirstlane(tid >> 6), lane = tid & 63, wr = wid >> 2, wc = wid & 3, fr = lane & 15, fq = lane >> 4;
    const int K = g.K, nt = K / BK;
    unsigned voffA[2], voffB[2];
#pragma unroll
    for (int i = 0; i < 2; ++i) { int R, C; stage_rc(tid * 16 + i * 8192, R, C); const int Rb = Epi::PERM ? ((R & ~31) + perm32(R & 31)) : R;
        voffA[i] = (unsigned)(R * K + C) * 2u; voffB[i] = (unsigned)(Rb * K + C) * 2u; }
    const size_t kstep = (size_t)(BK * 2);
    const size_t hstep = (size_t)HALF * K * 2;
    const size_t tstep = 2 * hstep;
    const unsigned ldsw = (unsigned)wid * 1024u;
    const int aoff = lds_byte(wr * 64 + fr, fq * 8), boff = lds_byte(wc * 32 + fr, fq * 8);
#define PG8_SA(b, h) (((b) * 2 + (h)) * HTB)
#define PG8_SB(b, h) ((4 + (b) * 2 + (h)) * HTB)
#define PG8_STAGE(bufoff, gbase, voff) do { _Pragma("unroll") for (int _i = 0; _i < 2; ++_i) \
        __builtin_amdgcn_global_load_lds((const unsigned*)((const char*)(gbase) + (voff)[_i]), (PG8_LAS unsigned*)(lds + (bufoff) + ldsw + _i * 8192), 16, 0, 0); } while (0)
#define PG8_LDA(dst, b, h) do { _Pragma("unroll") for (int m = 0; m < 4; ++m) _Pragma("unroll") for (int k = 0; k < 2; ++k) dst[m][k] = *(const PG8_LAS bf16x8*)(lds + PG8_SA(b, h) + aoff + m * 2048 + k * 1024); } while (0)
#define PG8_LDB(dst, b, h) do { _Pragma("unroll") for (int n = 0; n < 2; ++n) _Pragma("unroll") for (int k = 0; k < 2; ++k) dst[n][k] = *(const PG8_LAS bf16x8*)(lds + PG8_SB(b, h) + boff + n * 2048 + k * 1024); } while (0)
#define PG8_MMA(ai, bj, At, Bt) do { __builtin_amdgcn_s_setprio(1); _Pragma("unroll") for (int m = 0; m < 4; ++m) _Pragma("unroll") for (int n = 0; n < 2; ++n) _Pragma("unroll") for (int k = 0; k < 2; ++k) \
        acc[ai][bj][m][n] = __builtin_amdgcn_mfma_f32_16x16x32_bf16(Bt[n][k], At[m][k], acc[ai][bj][m][n], 0, 0, 0); __builtin_amdgcn_s_setprio(0); } while (0)
#define PG8_WAIT_V(n) asm volatile("s_waitcnt vmcnt(" #n ")" ::: "memory")
#define PG8_WAIT_L(n) asm volatile("s_waitcnt lgkmcnt(" #n ")" ::: "memory")
#define PG8_BAR __builtin_amdgcn_s_barrier()
#define PG8_SCHED __builtin_amdgcn_sched_barrier(0)
    Unit cur, nxt; int ui = 0;
    if (!S.next(0, cur)) return;
    f32x4 acc[2][2][4][2];
#pragma unroll
    for (int a = 0; a < 2; ++a)
#pragma unroll
        for (int b = 0; b < 2; ++b)
#pragma unroll
            for (int m = 0; m < 4; ++m)
#pragma unroll
                for (int n = 0; n < 2; ++n) acc[a][b][m][n] = (f32x4){0.f, 0.f, 0.f, 0.f};
    bf16x8 At[4][2], B0[2][2], B1[2][2];
    const char* cA = (const char*)g.A + (size_t)cur.pm * tstep; const char* cB = (const char*)g.Bt + (size_t)cur.pn * tstep;
    S.a_ready(cur);
    if constexpr (SP2) {
        PG8_STAGE(PG8_SB(0, 0), cB, voffB); PG8_STAGE(PG8_SB(0, 1), cB + hstep, voffB); PG8_STAGE(PG8_SA(0, 0), cA, voffA); PG8_STAGE(PG8_SA(0, 1), cA + hstep, voffA);
        if (wr == 1) PG8_BAR;
        PG8_WAIT_V(2); PG8_BAR;
        PG8_STAGE(PG8_SB(1, 0), cB + kstep, voffB); PG8_STAGE(PG8_SA(1, 0), cA + kstep, voffA); PG8_STAGE(PG8_SB(1, 1), cB + hstep + kstep, voffB);
        PG8_WAIT_V(6); PG8_BAR;
    } else {
        PG8_STAGE(PG8_SB(0, 0), cB, voffB); PG8_STAGE(PG8_SA(0, 0), cA, voffA); PG8_STAGE(PG8_SB(0, 1), cB + hstep, voffB); PG8_STAGE(PG8_SA(0, 1), cA + hstep, voffA);
        if (wr == 1) PG8_BAR;
        PG8_WAIT_V(4); PG8_BAR;
        PG8_STAGE(PG8_SB(1, 0), cB + kstep, voffB); PG8_STAGE(PG8_SA(1, 0), cA + kstep, voffA); PG8_STAGE(PG8_SB(1, 1), cB + hstep + kstep, voffB);
        PG8_WAIT_V(6); PG8_BAR;
    }
    for (;;) {
        const bool has_next = S.next(ui + 1, nxt);
        const char* nA = has_next ? (const char*)g.A + (size_t)nxt.pm * tstep : cA; const char* nB = has_next ? (const char*)g.Bt + (size_t)nxt.pn * tstep : cB;
        for (int t = 0; t < nt; t += 2) {
            const bool last = (t == nt - 2);
            const char* a1 = cA + (size_t)(t + 1) * kstep;
            const char* a2 = last ? nA : cA + (size_t)(t + 2) * kstep; const char* b2 = last ? nB : cB + (size_t)(t + 2) * kstep;
            const char* a3 = a2 + kstep; const char* b3 = b2 + kstep;
            if (last && has_next) S.a_ready(nxt);
            if constexpr (SP2) {
            PG8_LDB(B0, 0, 0); PG8_LDB(B1, 0, 1); PG8_SCHED; PG8_LDA(At, 0, 0); PG8_STAGE(PG8_SA(1, 1), a1 + hstep, voffA);
            PG8_WAIT_V(8); PG8_WAIT_L(0); PG8_BAR; PG8_MMA(0, 0, At, B0); PG8_MMA(0, 1, At, B1); PG8_BAR; PG8_SCHED;
            PG8_LDA(At, 0, 1); PG8_STAGE(PG8_SB(0, 0), b2, voffB); PG8_STAGE(PG8_SB(0, 1), b2 + hstep, voffB); PG8_STAGE(PG8_SA(0, 0), a2, voffA);
            PG8_WAIT_V(8); PG8_WAIT_L(0); PG8_BAR; PG8_MMA(1, 0, At, B0); PG8_MMA(1, 1, At, B1); PG8_BAR; PG8_SCHED;
            PG8_LDB(B0, 1, 0); PG8_LDB(B1, 1, 1); PG8_SCHED; PG8_LDA(At, 1, 0); PG8_STAGE(PG8_SA(0, 1), a2 + hstep, voffA);
            PG8_WAIT_V(8); PG8_WAIT_L(0); PG8_BAR; PG8_MMA(0, 0, At, B0); PG8_MMA(0, 1, At, B1); PG8_BAR; PG8_SCHED;
            PG8_LDA(At, 1, 1); PG8_STAGE(PG8_SB(1, 0), b3, voffB); PG8_STAGE(PG8_SB(1, 1), b3 + hstep, voffB); PG8_STAGE(PG8_SA(1, 0), a3, voffA);
            PG8_WAIT_V(8); PG8_WAIT_L(0); PG8_BAR; PG8_MMA(1, 0, At, B0); PG8_MMA(1, 1, At, B1); PG8_BAR; PG8_SCHED;
            } else {
            PG8_LDB(B0, 0, 0); PG8_SCHED; PG8_LDA(At, 0, 0); PG8_STAGE(PG8_SA(1, 1), a1 + hstep, voffA);
            PG8_WAIT_L(8); PG8_BAR; PG8_WAIT_L(0); PG8_MMA(0, 0, At, B0); PG8_BAR; PG8_SCHED;
            PG8_LDB(B1, 0, 1); PG8_STAGE(PG8_SB(0, 0), b2, voffB);
            PG8_BAR; PG8_WAIT_L(0); PG8_MMA(0, 1, At, B1); PG8_BAR;
            PG8_LDA(At, 0, 1); PG8_STAGE(PG8_SA(0, 0), a2, voffA);
            PG8_BAR; PG8_WAIT_L(0); PG8_MMA(1, 0, At, B0); PG8_BAR; PG8_SCHED;
            PG8_STAGE(PG8_SB(0, 1), b2 + hstep, voffB);
            PG8_WAIT_V(6); PG8_BAR; PG8_MMA(1, 1, At, B1); PG8_BAR;
            PG8_LDB(B0, 1, 0); PG8_SCHED; PG8_LDA(At, 1, 0); PG8_STAGE(PG8_SA(0, 1), a2 + hstep, voffA);
            PG8_WAIT_L(8); PG8_BAR; PG8_WAIT_L(0); PG8_MMA(0, 0, At, B0); PG8_BAR; PG8_SCHED;
            PG8_LDB(B1, 1, 1); PG8_STAGE(PG8_SB(1, 0), b3, voffB);
            PG8_BAR; PG8_WAIT_L(0); PG8_MMA(0, 1, At, B1); PG8_BAR;
            PG8_LDA(At, 1, 1); PG8_STAGE(PG8_SA(1, 0), a3, voffA);
            PG8_BAR; PG8_WAIT_L(0); PG8_MMA(1, 0, At, B0); PG8_BAR; PG8_SCHED;
            PG8_STAGE(PG8_SB(1, 1), b3 + hstep, voffB);
            PG8_WAIT_V(6); PG8_BAR; PG8_MMA(1, 1, At, B1); PG8_BAR;
            }
        }
        if constexpr (ALIGN_EPI) { if (wr == 0) PG8_BAR; }
        if constexpr (!Epi::AFTER_DRAIN) { E(acc, cur, wr, wc, fr, fq); S.done(cur); }
        if (!has_next) break;
#pragma unroll
        for (int a = 0; a < 2; ++a)
#pragma unroll
            for (int b = 0; b < 2; ++b)
#pragma unroll
                for (int m = 0; m < 4; ++m)
#pragma unroll
                    for (int n = 0; n < 2; ++n) acc[a][b][m][n] = (f32x4){0.f, 0.f, 0.f, 0.f};
        cur = nxt; cA = nA; cB = nB; ++ui;
        if constexpr (ALIGN_EPI) { if (wr == 1) PG8_BAR; }
    }
    PG8_WAIT_V(0);
    if constexpr (!ALIGN_EPI) { if (wr == 0) PG8_BAR; }
    PG8_BAR;
    if constexpr (Epi::AFTER_DRAIN) { E.fused(acc, cur, wr, wc, fr, fq, lds, wid, lane); S.done(cur); }
#undef PG8_SA
#undef PG8_SB
#undef PG8_STAGE
#undef PG8_LDA
#undef PG8_LDB
#undef PG8_MMA
#undef PG8_WAIT_V
#undef PG8_WAIT_L
#undef PG8_BAR
#undef PG8_SCHED
}
}

using pg8::bf16_t; using pg8::bf16x8; using pg8::f32x4; using pg8::u32x4;
typedef float f32x16 __attribute__((ext_vector_type(16)));
typedef short s16x4 __attribute__((ext_vector_type(4)));
typedef unsigned u32x2 __attribute__((ext_vector_type(2)));
#define LAS __attribute__((address_space(3)))

constexpr int DM = 2048, NB = 4, SEQ = 4096, CTXL = 256, NLAT = NB * SEQ, NCTX = NB * CTXL, MROWS = NLAT + NCTX, DIN = 7168;
constexpr int C_Q = 2048, C_K = 3072, C_V = 4096, C_AG = 5120, C_PU = 6144, C_PG = 6656;
constexpr float LN_EPS = 1e-5f, RMS_EPS = 1e-5f;
constexpr float ALPHA = 1.4142135623730951f;
constexpr float QSCALE = 0.125f * 1.4426950408889634f;
constexpr int NTHREADS = 512;
constexpr int LDS_BYTES = 147456 + 1024;

constexpr size_t OFF_WTIN = 1u << 20;
constexpr size_t OFF_WTOUT = OFF_WTIN + (size_t)2 * DIN * DM * 2;
constexpr size_t OFF_PWT = OFF_WTOUT + (size_t)2 * DM * DM * 2;
constexpr size_t OFF_MODP = OFF_PWT + 262144;
constexpr size_t OFF_MODF = OFF_MODP + 983040;
constexpr size_t OFF_ROPE = OFF_MODF + 245760;
constexpr size_t OFF_HY = OFF_ROPE + 8192;
constexpr size_t OFF_P = OFF_HY + (size_t)MROWS * DM * 2;
constexpr size_t OFF_ZC = OFF_P + (size_t)MROWS * DIN * 2;
constexpr size_t OFF_O1 = OFF_ZC + (size_t)NCTX * DM * 4;
constexpr size_t WS_END = OFF_O1 + (size_t)256 * 256 * 128 * 4;

struct Params {
    const float *x, *c, *ctx, *c_ctx, *w_mod, *b_mod, *w_in, *conv_w, *lq1, *lk1, *lq2, *lk2, *subln_g, *pool_w, *pool_scale, *w_out, *ln_g, *ln_b;
    float* out; unsigned char* ws;
};

__device__ __forceinline__ float silu_f(float v) { return v / (1.f + __expf(-v)); }
__device__ __forceinline__ float bf2f(unsigned short b) { return __uint_as_float(((unsigned)b) << 16); }
__device__ __forceinline__ float bflo(unsigned w) { return __uint_as_float(w << 16); }
__device__ __forceinline__ float bfhi(unsigned w) { return __uint_as_float(w & 0xffff0000u); }
__device__ __forceinline__ unsigned pk2(float lo, float hi) { return pg8::cvt_pk_bf16(lo, hi); }
__device__ __forceinline__ float wave_sum(float v) {
#pragma unroll
    for (int o = 32; o >= 1; o >>= 1) v += __shfl_xor(v, o);
    return v;
}

__device__ __forceinline__ int rope_src(int j) { const int part = j >> 5, jj = j & 31; return part * 32 + (jj & 1) * 16 + (jj >> 1); }

__device__ __forceinline__ void transpose_tile(const float* __restrict__ src, int K, int N, bf16_t* __restrict__ dst, int k0, int n0, bool permq, LAS float* tile) {
    const int tid = otid();
    { const int r = tid >> 4, c4 = (tid & 15) * 4;
#pragma unroll
      for (int i = 0; i < 2; ++i) { const int k = r + 32 * i; const f32x4 v = *(const f32x4*)(src + (size_t)(k0 + k) * N + n0 + c4);
          tile[k * 65 + c4 + 0] = v[0]; tile[k * 65 + c4 + 1] = v[1]; tile[k * 65 + c4 + 2] = v[2]; tile[k * 65 + c4 + 3] = v[3]; } }
    __syncthreads();
    { const int n = tid >> 3, kc = (tid & 7) * 8; const int ns = permq ? rope_src(n) : n;
      float f[8];
#pragma unroll
      for (int j = 0; j < 8; ++j) f[j] = tile[(kc + j) * 65 + ns];
      u32x4 w; w.x = pk2(f[0], f[1]); w.y = pk2(f[2], f[3]); w.z = pk2(f[4], f[5]); w.w = pk2(f[6], f[7]);
      *(u32x4*)(dst + (size_t)(n0 + n) * K + k0 + kc) = w; }
    __syncthreads();
}

__device__ __forceinline__ void gemv_item(const Params& p, int item, LAS float* lds) {
    const int l = item / 192, rem = item % 192, kq = rem / 48, cgp = rem % 48, tid = threadIdx.x;
    LAS float* s = lds; LAS float* red = lds + 2560;
    float* MODP = (float*)(p.ws + OFF_MODP);
#pragma unroll
    for (int r = 0; r < 5; ++r) { const int k = kq * 512 + tid; const float v = (r < 4) ? p.c[r * DM + k] : p.c_ctx[k]; s[r * 512 + tid] = silu_f(v); }
    __syncthreads();
    const int kl = tid >> 5, c4 = tid & 31;
    const float* W = p.w_mod + (size_t)l * DM * 6144 + (size_t)(kq * 512) * 6144 + cgp * 128 + c4 * 4;
    f32x4 acc[5];
#pragma unroll
    for (int r = 0; r < 5; ++r) acc[r] = (f32x4){0.f, 0.f, 0.f, 0.f};
#pragma unroll 4
    for (int i = 0; i < 32; ++i) { const int k = kl + 16 * i; const f32x4 w = *(const f32x4*)(W + (size_t)k * 6144);
#pragma unroll
        for (int r = 0; r < 5; ++r) { const float sv = s[r * 512 + k]; acc[r] += w * sv; } }
#pragma unroll
    for (int r = 0; r < 5; ++r) { LAS float* q = red + (kl * 5 + r) * 128 + c4 * 4; q[0] = acc[r][0]; q[1] = acc[r][1]; q[2] = acc[r][2]; q[3] = acc[r][3]; }
    __syncthreads();
    for (int o = tid; o < 640; o += NTHREADS) { const int r = o >> 7, cc = o & 127; float sum = 0.f;
#pragma unroll
        for (int k2 = 0; k2 < 16; ++k2) sum += red[(k2 * 5 + r) * 128 + cc];
        MODP[(size_t)((l * 4 + kq) * 5 + r) * 6144 + cgp * 128 + cc] = sum; }
    __syncthreads();
}

constexpr int N_GEMV = 384, N_TIN = 3584, N_TOUT = 1024, N_TPOOL = 32;
constexpr int IT_TIN = N_GEMV, IT_TOUT = IT_TIN + 2 * N_TIN, IT_TPOOL = IT_TOUT + 2 * N_TOUT, IT_ROPE = IT_TPOOL + N_TPOOL, N_ITEMS0 = IT_ROPE + 1;

__device__ __forceinline__ void phase0(const Params& p, LAS unsigned char* lds) {
    LAS float* fl = (LAS float*)lds;
    for (int it = blockIdx.x; it < N_ITEMS0; it += gridDim.x) {
        if (it < IT_TIN) gemv_item(p, it, fl);
        else if (it < IT_TOUT) { const int q = it - IT_TIN, l = q / N_TIN, t = q % N_TIN, tk = t / 112, tn = t % 112;
            transpose_tile(p.w_in + (size_t)l * DM * DIN, DM, DIN, (bf16_t*)(p.ws + OFF_WTIN) + (size_t)l * DIN * DM, tk * 64, tn * 64, (tn * 64 >= C_Q && tn * 64 < C_V), fl); }
        else if (it < IT_TPOOL) { const int q = it - IT_TOUT, l = q / N_TOUT, t = q % N_TOUT, tk = t / 32, tn = t % 32;
            transpose_tile(p.w_out + (size_t)l * DM * DM, DM, DM, (bf16_t*)(p.ws + OFF_WTOUT) + (size_t)l * DM * DM, tk * 64, tn * 64, false, fl); }
        else if (it < IT_ROPE) { const int q = it - IT_TPOOL, mtx = q >> 2, tk = (q >> 1) & 1, tn = q & 1;
            transpose_tile(p.pool_w + (size_t)mtx * 128 * 128, 128, 128, (bf16_t*)(p.ws + OFF_PWT) + (size_t)mtx * 128 * 128, tk * 64, tn * 64, false, fl); }
        else { float* rope = (float*)(p.ws + OFF_ROPE);
            for (int e = otid(); e < 1024; e += NTHREADS) { const int pos = e >> 4, i = e & 15;
                const float inv = exp2f(-(float)i * 0.830482023721841f);
                const float ang = (float)pos * inv; float sn, cs; sincosf(ang, &sn, &cs);
                rope[2 * e] = cs; rope[2 * e + 1] = sn; } }
    }
}

__device__ __forceinline__ void phase_mod0(const Params& p) {
    const int tid = otid(), G = gridDim.x, blk = blockIdx.x;
    const float* MODP = (const float*)(p.ws + OFF_MODP); float* MODF = (float*)(p.ws + OFF_MODF);
    bf16_t* H = (bf16_t*)(p.ws + OFF_HY);
    for (int idx = blk * NTHREADS + tid; idx < 2 * 5 * 6144; idx += G * NTHREADS) {
        const int l = idx / 30720, rem = idx % 30720, r = rem / 6144, n = rem % 6144; float v = p.b_mod[l * 6144 + n];
#pragma unroll
        for (int kq = 0; kq < 4; ++kq) v += MODP[(size_t)((l * 4 + kq) * 5 + r) * 6144 + n];
        MODF[idx] = v; }
    const int per = (MROWS + G - 1) / G; int r0 = blk * per, r1 = r0 + per; if (r1 > MROWS) r1 = MROWS;
    const int col = 4 * tid;
    while (r0 < r1) {
        const int b = r0 < NLAT ? r0 / SEQ : 4; int rend = r0 < NLAT ? (b + 1) * SEQ : MROWS; if (rend > r1) rend = r1;
        f32x4 sh = *(const f32x4*)(p.b_mod + col), sc = *(const f32x4*)(p.b_mod + 2048 + col);
#pragma unroll
        for (int kq = 0; kq < 4; ++kq) { sh += *(const f32x4*)(MODP + (size_t)(kq * 5 + b) * 6144 + col); sc += *(const f32x4*)(MODP + (size_t)(kq * 5 + b) * 6144 + 2048 + col); }
        sc += 1.f;
#pragma unroll 4
        for (int row = r0; row < rend; ++row) {
            const float* src = row < NLAT ? p.x + (size_t)row * DM : p.ctx + (size_t)(row - NLAT) * DM;
            const f32x4 v = *(const f32x4*)(src + col); const f32x4 h = v * sc + sh;
            u32x2 w; w.x = pk2(h[0], h[1]); w.y = pk2(h[2], h[3]); *(u32x2*)(H + (size_t)row * DM + col) = w; }
        r0 = rend;
    }
}

struct OrderX {
    pg8::StaticOrder base; int nextra, epm0, epn0, epnn;
    __device__ __forceinline__ bool next(int i, pg8::Unit& u) const {
        const long L = (long)i * base.G + base.c; if (L < base.nwg) return base.next(i, u);
        const int e = (int)(L - base.nwg); if (e >= nextra) return false; u.pm = epm0 + e / epnn; u.pn = epn0 + e % epnn; return true; }
    __device__ __forceinline__ void a_ready(const pg8::Unit&) const {}
    __device__ __forceinline__ void done(const pg8::Unit&) const {}
};

struct EpiIn {
    static constexpr bool PERM = true, AFTER_DRAIN = false;
    bf16_t* P; const float* rope;
    __device__ __forceinline__ void operator()(const f32x4 (&acc)[2][2][4][2], const pg8::Unit& u, int wr, int wc, int fr, int fq) const {
        const bool isq = (u.pn >= 8 && u.pn < 12), isk = (u.pn >= 12 && u.pn < 16);
        const bool dorope = (isq || isk) && (u.pm < 64);
        const float qs = isq ? QSCALE : 1.f;
#pragma unroll
        for (int ai = 0; ai < 2; ++ai)
#pragma unroll
            for (int m = 0; m < 4; ++m) {
                const int row = u.pm * 256 + ai * 128 + wr * 64 + m * 16 + fr; const int t = row & 4095, prow = t >> 6, pcol = t & 63;
#pragma unroll
                for (int bj = 0; bj < 2; ++bj) {
                    const int col0 = u.pn * 256 + bj * 128 + wc * 32 + 8 * fq;
                    f32x4 v0 = acc[ai][bj][m][0], v1 = acc[ai][bj][m][1];
                    if (dorope) { const int part = (col0 >> 5) & 1, i0 = (col0 & 31) >> 1, pos = part ? pcol : prow; const float* rp = rope + (pos * 16 + i0) * 2;
                        const f32x4 c0 = *(const f32x4*)rp, c1 = *(const f32x4*)(rp + 4); float a, b;
                        a = v0[0]; b = v0[1]; v0[0] = a * c0[0] - b * c0[1]; v0[1] = a * c0[1] + b * c0[0];
                        a = v0[2]; b = v0[3]; v0[2] = a * c0[2] - b * c0[3]; v0[3] = a * c0[3] + b * c0[2];
                        a = v1[0]; b = v1[1]; v1[0] = a * c1[0] - b * c1[1]; v1[1] = a * c1[1] + b * c1[0];
                        a = v1[2]; b = v1[3]; v1[2] = a * c1[2] - b * c1[3]; v1[3] = a * c1[3] + b * c1[2]; }
                    v0 = v0 * qs; v1 = v1 * qs;
                    u32x4 w; w.x = pk2(v0[0], v0[1]); w.y = pk2(v0[2], v0[3]); w.z = pk2(v1[0], v1[1]); w.w = pk2(v1[2], v1[3]);
                    *(u32x4*)(P + (size_t)row * DIN + col0) = w; } }
    }
};

struct EpiOut {
    static constexpr bool PERM = true, AFTER_DRAIN = false;
    const float* xlat; const float* xctx; float* olat; float* octx; const float* gate;
    __device__ __forceinline__ void operator()(const f32x4 (&acc)[2][2][4][2], const pg8::Unit& u, int wr, int wc, int fr, int fq) const {
        const bool lat = u.pm < 64;
#pragma unroll
        for (int ai = 0; ai < 2; ++ai)
#pragma unroll
            for (int m = 0; m < 4; ++m) {
                const int row = u.pm * 256 + ai * 128 + wr * 64 + m * 16 + fr; const int b = lat ? (row >> 12) : 4;
                const float* xr = lat ? xlat + (size_t)row * DM : xctx + (size_t)(row - NLAT) * DM;
                float* orow = lat ? olat + (size_t)row * DM : octx + (size_t)(row - NLAT) * DM;
                const float* gr = gate + b * 6144;
#pragma unroll
                for (int bj = 0; bj < 2; ++bj) {
                    const int col0 = u.pn * 256 + bj * 128 + wc * 32 + 8 * fq;
                    const f32x4 g0 = *(const f32x4*)(gr + col0), g1 = *(const f32x4*)(gr + col0 + 4);
                    const f32x4 x0 = *(const f32x4*)(xr + col0), x1 = *(const f32x4*)(xr + col0 + 4);
                    const f32x4 z0 = x0 * ALPHA + g0 * acc[ai][bj][m][0], z1 = x1 * ALPHA + g1 * acc[ai][bj][m][1];
                    *(f32x4*)(orow + col0) = z0; *(f32x4*)(orow + col0 + 4) = z1; } }
    }
};

namespace att {
constexpr int SHM_V = 16384, SHM_K = 8192, NSLOT = 3;
constexpr int LDS_K = 0, LDS_V = NSLOT * SHM_K, LDS_WS = LDS_V + NSLOT * SHM_V, LDS_TOTAL = LDS_WS + 8 * 64 * 4;
constexpr float THRL = 8.f;
#define KSW(row, chunk) ((row) * 128 + ((((chunk) ^ (((row) >> 1) & 7))) << 4))
#define SBAR() __builtin_amdgcn_sched_barrier(0)
__device__ __forceinline__ int crow(int r, int hi) { return (r & 3) + 8 * (r >> 2) + 4 * hi; }
__device__ __forceinline__ unsigned cvtpk(float lo, float hi) { unsigned r; asm volatile("v_cvt_pk_bf16_f32 %0, %1, %2" : "=v"(r) : "v"(lo), "v"(hi)); return r; }

__device__ __forceinline__ float max3f(float a, float b, float c) { float r; asm("v_max3_f32 %0, %1, %2, %3" : "=v"(r) : "v"(a), "v"(b), "v"(c)); return r; }
template <bool FIRST, int VAR = 0>
__device__ __forceinline__ void partialSM(f32x16& p0, f32x16& p1, float& mref) {
    if (FIRST) {
        float pmax = max3f(p0[0], p0[1], p1[0]); pmax = max3f(pmax, p1[1], p0[2]);
#pragma unroll
        for (int r = 2; r < 16; r += 2) { pmax = max3f(pmax, p1[r], p1[r + 1]); if (r + 2 < 16) pmax = max3f(pmax, p0[r + 1], p0[r + 2]); else pmax = fmaxf(pmax, p0[r + 1]); }
        { auto rr = __builtin_amdgcn_permlane32_swap(__float_as_uint(pmax), __float_as_uint(pmax), false, false);
          pmax = fmaxf(__uint_as_float(rr[0]), __uint_as_float(rr[1])); }
        mref = pmax;
    }
    const float mn = mref;
#pragma unroll
    for (int r = 0; r < 16; ++r) p0[r] = (VAR & 1) ? (p0[r] - mn) * 0.001f : __builtin_amdgcn_exp2f(p0[r] - mn);
}
template <int VAR = 0>
__device__ __forceinline__ float finishSM(f32x16& p0, f32x16& p1, float& mref, float& l_reg, bf16x8& pa0, bf16x8& pa1, bf16x8& pa2, bf16x8& pa3) {
    const float mn = mref;
#pragma unroll
    for (int r = 0; r < 16; ++r) p1[r] = (VAR & 1) ? (p1[r] - mn) * 0.001f : __builtin_amdgcn_exp2f(p1[r] - mn);
    float ps = 0;
#pragma unroll
    for (int r = 0; r < 16; ++r) ps += p0[r];
#pragma unroll
    for (int r = 0; r < 16; ++r) ps += p1[r];
    { auto rr = __builtin_amdgcn_permlane32_swap(__float_as_uint(ps), __float_as_uint(ps), false, false);
      ps = __uint_as_float(rr[0]) + __uint_as_float(rr[1]); }
    float f = 1.f;
    if (__builtin_expect(__any(ps > 16777216.f), 0)) {
        if (ps > 16777216.f) { const int e = ((__float_as_uint(ps) >> 23) & 0xff) - 127; f = __uint_as_float((unsigned)(127 - e) << 23); mref += (float)e; }
#pragma unroll
        for (int r = 0; r < 16; ++r) { p0[r] *= f; p1[r] *= f; }
        ps *= f; l_reg *= f;
    }
    l_reg += ps;
#define PK4(P, BASE, OUT) do { unsigned a0 = cvtpk(P[BASE + 0], P[BASE + 1]), a1 = cvtpk(P[BASE + 2], P[BASE + 3]);   \
    unsigned b0 = cvtpk(P[BASE + 4], P[BASE + 5]), b1 = cvtpk(P[BASE + 6], P[BASE + 7]);                              \
    auto r0 = __builtin_amdgcn_permlane32_swap(a0, b0, false, false); auto r1 = __builtin_amdgcn_permlane32_swap(a1, b1, false, false); \
    u32x4 w = {r0[0], r1[0], r0[1], r1[1]}; OUT = *reinterpret_cast<bf16x8*>(&w); } while (0)
    PK4(p0, 0, pa0); PK4(p0, 8, pa1); PK4(p1, 0, pa2); PK4(p1, 8, pa3);
#undef PK4
    return f;
}
__device__ __forceinline__ void qkt(f32x16& p0, f32x16& p1, const LAS char* Ks, const bf16x8* qr, int r32, int hi) {
#pragma unroll
    for (int d0 = 0; d0 < 4; ++d0) { const int ch = d0 * 2 + hi;
        bf16x8 b0 = *(const LAS bf16x8*)(Ks + KSW(r32, ch));
        bf16x8 b1 = *(const LAS bf16x8*)(Ks + KSW(32 + r32, ch));
        if (d0 == 0) { p0 = __builtin_amdgcn_mfma_f32_32x32x16_bf16(b0, qr[0], f32x16{}, 0, 0, 0); p1 = __builtin_amdgcn_mfma_f32_32x32x16_bf16(b1, qr[0], f32x16{}, 0, 0, 0); }
        else { p0 = __builtin_amdgcn_mfma_f32_32x32x16_bf16(b0, qr[d0], p0, 0, 0, 0); p1 = __builtin_amdgcn_mfma_f32_32x32x16_bf16(b1, qr[d0], p1, 0, 0, 0); } }
}
__device__ __forceinline__ int v_st(int k, int c) { const int kk = (k & ~0xC) | ((k & 4) << 1) | ((k & 8) >> 1); return ((kk >> 3) * 4 + (c >> 5)) * 512 + ((kk & 7) * 32 + (c & 31)) * 2; }
__device__ __forceinline__ int v_rd_base(int lane) { return ((lane & 3) << 3) | (((lane >> 2) & 3) << 6) | (((lane >> 4) & 1) << 5) | (((lane >> 5) & 1) << 8); }
constexpr int v_rd_off(int d0, int ks, int half) { return d0 * 512 + ks * 4096 + half * 2048; }
template <int OFF> __device__ __forceinline__ s16x4 tr_read(int vb) {
    s16x4 r; asm volatile("ds_read_b64_tr_b16 %0, %1 offset:%2" : "=&v"(r) : "v"(vb), "i"(OFF) : "memory"); return r;
}
#define RD8(D0, X) const s16x4 X##0 = tr_read<v_rd_off(D0, 0, 0)>(vb), X##1 = tr_read<v_rd_off(D0, 0, 1)>(vb), X##2 = tr_read<v_rd_off(D0, 1, 0)>(vb), X##3 = tr_read<v_rd_off(D0, 1, 1)>(vb), \
    X##4 = tr_read<v_rd_off(D0, 2, 0)>(vb), X##5 = tr_read<v_rd_off(D0, 2, 1)>(vb), X##6 = tr_read<v_rd_off(D0, 3, 0)>(vb), X##7 = tr_read<v_rd_off(D0, 3, 1)>(vb)
#define WDEP(N, X) s16x4 X##w0 = X##0, X##w1 = X##1, X##w2 = X##2, X##w3 = X##3, X##w4 = X##4, X##w5 = X##5, X##w6 = X##6, X##w7 = X##7; \
    asm volatile("s_waitcnt lgkmcnt(" #N ")" : "+v"(X##w0), "+v"(X##w1), "+v"(X##w2), "+v"(X##w3), "+v"(X##w4), "+v"(X##w5), "+v"(X##w6), "+v"(X##w7) :: "memory")
#define PKV(L, H) (bf16x8){L[0], L[1], L[2], L[3], H[0], H[1], H[2], H[3]}
#define MM4(od, X) od = __builtin_amdgcn_mfma_f32_32x32x16_bf16(pa0, PKV(X##w0, X##w1), od, 0, 0, 0); od = __builtin_amdgcn_mfma_f32_32x32x16_bf16(pa1, PKV(X##w2, X##w3), od, 0, 0, 0); \
    od = __builtin_amdgcn_mfma_f32_32x32x16_bf16(pa2, PKV(X##w4, X##w5), od, 0, 0, 0); od = __builtin_amdgcn_mfma_f32_32x32x16_bf16(pa3, PKV(X##w6, X##w7), od, 0, 0, 0)
__device__ __forceinline__ void pv_d0(f32x16* o, int vb, bf16x8 pa0, bf16x8 pa1, bf16x8 pa2, bf16x8 pa3) {
    RD8(0, a);
    RD8(1, b); WDEP(8, a); MM4(o[0], a);
    RD8(2, c); WDEP(8, b); MM4(o[1], b);
    RD8(3, d); WDEP(8, c); MM4(o[2], c);
    WDEP(0, d); MM4(o[3], d);
}
#undef RD8
#undef WDEP
#undef PKV
#undef MM4

template <int VAR>
__device__ __forceinline__ void attn_map(const bf16_t* __restrict__ Qw, const bf16_t* __restrict__ Kc, const bf16_t* __restrict__ Vc, int ctx_row0, int lat_row0, int nct, int NT,
                                         LAS char* lds, f32x16 (&o)[4], float& l_out) {
    const int tid = otid(), wid = __builtin_amdgcn_readfirstlane(tid >> 6), lane = tid & 63, r32 = lane & 31, hi = lane >> 5;
    LAS char* V_lds = lds + LDS_V; LAS char* K_lds = lds + LDS_K;
    LAS float* ws = (LAS float*)(lds + LDS_WS) + wid * 64; LAS float* al_l = ws + 32;
    float m_reg = 0.f, l_reg = 0;
#pragma unroll
    for (int d = 0; d < 4; ++d) o[d] = f32x16{};
    const int krow = wid * 8 + (lane >> 3), kchunk = (lane & 7) ^ ((krow >> 1) & 7);
    const bf16_t* ksrc = Kc + (size_t)krow * DIN + kchunk * 8;
    const int kk = wid * 8 + ((lane & 31) >> 2), kkey = (kk & ~0xC) | ((kk & 4) << 1) | ((kk & 8) >> 1);
    const bf16_t* vsrc0 = Vc + (size_t)kkey * DIN + hi * 32 + (lane & 3) * 8;
    const int vb0 = (int)(uintptr_t)V_lds + v_rd_base(lane);
#define KROW(t) (((t) < nct) ? (ctx_row0 + (t) * 64) : (lat_row0 + ((t) - nct) * 64))
#define DMA(t, slot) do { const size_t ro_ = (size_t)KROW(t) * DIN; \
    __builtin_amdgcn_global_load_lds((const unsigned*)(ksrc + ro_), (LAS unsigned*)(K_lds + (slot) * SHM_K + wid * 1024), 16, 0, 0); \
    __builtin_amdgcn_global_load_lds((const unsigned*)(vsrc0 + ro_), (LAS unsigned*)(V_lds + (slot) * SHM_V + wid * 2048), 16, 0, 0); \
    __builtin_amdgcn_global_load_lds((const unsigned*)(vsrc0 + ro_ + 64), (LAS unsigned*)(V_lds + (slot) * SHM_V + wid * 2048 + 1024), 16, 0, 0); } while (0)
#define WAIT_BAR(N) asm volatile("s_waitcnt vmcnt(" #N ") lgkmcnt(0)\n\ts_barrier" ::: "memory")
#define RESC(a) do { if (__any((a) < 1.f)) { if (hi == 0) al_l[r32] = (a); asm volatile("s_waitcnt lgkmcnt(0)" ::: "memory"); \
    _Pragma("unroll") for (int d = 0; d < 4; ++d) _Pragma("unroll") for (int r = 0; r < 16; ++r) o[d][r] *= al_l[crow(r, hi)]; } } while (0)
#define STEP(C0, C1, alC, P0, P1, alP, t, GD) do { WAIT_BAR(0); \
    if (GD && !(VAR & 2)) { DMA((t) + 1, sn); } SBAR(); \
    qkt(C0, C1, K_lds + sc_ * SHM_K, qr, r32, hi); \
    { const float f_ = finishSM<VAR>(P0, P1, m_reg, l_reg, pa0, pa1, pa2, pa3); RESC(f_); } SBAR(); \
    if (!(VAR & 4)) pv_d0(o, vb0 + sp * SHM_V, pa0, pa1, pa2, pa3); partialSM<false, VAR>(C0, C1, m_reg); \
    sp = sc_; sc_ = sn; sn = (sn == NSLOT - 1) ? 0 : sn + 1; } while (0)
    f32x16 pA0, pA1, pB0, pB1; const float alA = 1.f, alB = 1.f; bf16x8 pa0, pa1, pa2, pa3; (void)alA; (void)alB;
    WAIT_BAR(0);
    bf16x8 qr[4];
#pragma unroll
    for (int d0 = 0; d0 < 4; ++d0) qr[d0] = *reinterpret_cast<const bf16x8*>(Qw + d0 * 16);
    if (!(VAR & 2)) { DMA(0, 0); DMA(1, 1); }
    WAIT_BAR(3);
    qkt(pA0, pA1, K_lds, qr, r32, hi); partialSM<true, VAR>(pA0, pA1, m_reg);
    int sp = 0, sc_ = 1, sn = 2;
    for (int j = 1; j + 1 < NT; j += 2) {
        STEP(pB0, pB1, alB, pA0, pA1, alA, j, true);
        STEP(pA0, pA1, alA, pB0, pB1, alB, j + 1, true);
    }
    STEP(pB0, pB1, alB, pA0, pA1, alA, NT - 1, false);
    { const float f_ = finishSM<VAR>(pB0, pB1, m_reg, l_reg, pa0, pa1, pa2, pa3); RESC(f_); } SBAR();
    pv_d0(o, vb0 + sp * SHM_V, pa0, pa1, pa2, pa3);
    l_out = l_reg;
#undef KROW
#undef DMA
#undef WAIT_BAR
#undef RESC
#undef STEP
}

constexpr int LDS_OB = 0, LDS_OA = 81920, LDS_ATT_END = LDS_OA + 65536;
static_assert(LDS_TOTAL <= LDS_OA, "attention LDS map");
template <int VAR = 0>
__device__ __forceinline__ void attn_unit(const Params& p, int l, int h, int qrow0, int ctx_row0, int lat_row0, int nct, int NT, float lam, float oml, LAS char* lds, bf16_t* Y) {
    const int tid = otid(), wid = tid >> 6, lane = tid & 63, r32 = lane & 31, hi = lane >> 5;
    const bf16_t* P = (const bf16_t*)(p.ws + OFF_P);
    LAS float* li_l = (LAS float*)(lds + LDS_WS) + wid * 64;
    f32x16 o[4]; float l_reg;
#ifndef MPN
#define MPN 2
#endif
#pragma unroll
    for (int mp = 0; mp < MPN; ++mp) {
        const bf16_t* Qw = P + (size_t)(qrow0 + wid * 32 + r32) * DIN + C_Q + h * 128 + mp * 64 + hi * 8;
        attn_map<VAR>(Qw, P + C_K + h * 128 + mp * 64, P + C_V + h * 128, ctx_row0, lat_row0, nct, NT, lds, o, l_reg);
        if (hi == 0) li_l[r32] = l_reg; asm volatile("s_waitcnt lgkmcnt(0)" ::: "memory");
        float rli[16];
#pragma unroll
        for (int r = 0; r < 16; ++r) rli[r] = __builtin_amdgcn_rcpf(li_l[crow(r, hi)]);
        if (mp == 1) __syncthreads();
        LAS bf16_t* ol = (LAS bf16_t*)(lds + (mp == 0 ? LDS_OA : LDS_OB)) + (wid * 32 + 4 * hi) * 128 + r32;
#pragma unroll
        for (int r = 0; r < 16; ++r)
#pragma unroll
            for (int d0 = 0; d0 < 4; ++d0) ol[((r & 3) + 8 * (r >> 2)) * 128 + d0 * 32] = (bf16_t)(cvtpk(o[d0][r] * rli[r], 0.f) & 0xffffu);
        if (mp == 1) {
            asm volatile("s_waitcnt lgkmcnt(0)" ::: "memory");
            int c4 = r32 * 4; asm volatile("" : "+v"(c4));
            const f32x4 g4 = *(const f32x4*)(p.subln_g + l * 128 + c4) * oml;
            const LAS bf16_t* A = (const LAS bf16_t*)(lds + LDS_OA) + (wid * 32 + hi) * 128 + c4;
            const LAS bf16_t* B = (const LAS bf16_t*)(lds + LDS_OB) + (wid * 32 + hi) * 128 + c4;
            const bf16_t* agp = P + (size_t)(qrow0 + wid * 32 + hi) * DIN + C_AG + h * 128 + c4;
            bf16_t* yp = Y + (size_t)(qrow0 + wid * 32 + hi) * DM + 512 + h * 128 + c4;
#pragma unroll 2
            for (int st = 0; st < 16; ++st) {
                const u32x2 av = *(const LAS u32x2*)(A + st * 256), bv = *(const LAS u32x2*)(B + st * 256);
                const u32x2 ag = *(const u32x2*)(agp + (size_t)(st * 2) * DIN);
                const float f0 = bflo(av.x) - lam * bflo(bv.x), f1 = bfhi(av.x) - lam * bfhi(bv.x), f2 = bflo(av.y) - lam * bflo(bv.y), f3 = bfhi(av.y) - lam * bfhi(bv.y);
                float ss = (f0 * f0 + f1 * f1) + (f2 * f2 + f3 * f3);
#pragma unroll
                for (int off = 1; off < 32; off <<= 1) ss += __shfl_xor(ss, off);
                const float rstd = __builtin_amdgcn_rsqf(ss * (1.f / 128.f) + RMS_EPS);
                const float y0 = f0 * rstd * g4[0] * silu_f(bflo(ag.x)), y1 = f1 * rstd * g4[1] * silu_f(bfhi(ag.x));
                const float y2 = f2 * rstd * g4[2] * silu_f(bflo(ag.y)), y3 = f3 * rstd * g4[3] * silu_f(bfhi(ag.y));
                u32x2 w; w.x = cvtpk(y0, y1); w.y = cvtpk(y2, y3);
                *(u32x2*)(yp + (size_t)(st * 2) * DM) = w;
            }
        }
    }
}
#undef KSW
#undef SBAR
}

__device__ __forceinline__ void seq_bounds(int R0, int& s0, int& s1) { if (R0 < NLAT) { s0 = R0 & ~(SEQ - 1); s1 = s0 + SEQ; } else { s0 = NLAT + ((R0 - NLAT) & ~(CTXL - 1)); s1 = s0 + CTXL; } }

__device__ __forceinline__ void unpack8(const u32x4 w, float (&f)[8]) { f[0] = bflo(w.x); f[1] = bfhi(w.x); f[2] = bflo(w.y); f[3] = bfhi(w.y); f[4] = bflo(w.z); f[5] = bfhi(w.z); f[6] = bflo(w.w); f[7] = bfhi(w.w); }

__device__ __forceinline__ void conv_item(const Params& p, int l, int rt) {
    const int tid = otid(), ch0 = (tid & 63) * 8, R0 = rt * 64, r0 = R0 + (tid >> 6) * 8; int s0, s1; seq_bounds(R0, s0, s1);
    const bf16_t* P = (const bf16_t*)(p.ws + OFF_P); bf16_t* Y = (bf16_t*)(p.ws + OFF_HY);
    const float* cw = p.conv_w + l * 3 * 512 + ch0;
    float w0[8], w1[8], w2[8];
#pragma unroll
    for (int j = 0; j < 8; ++j) { w0[j] = cw[j]; w1[j] = cw[512 + j]; w2[j] = cw[1024 + j]; }
#define LD16(row, sect) (*(const u32x4*)(P + (size_t)(row) * DIN + (sect) * 512 + ch0))
    float vp[8], vc[8], vn[8], a[8], b[8];
#pragma unroll
    for (int j = 0; j < 8; ++j) vp[j] = 0.f;
    if (r0 - 1 >= s0) { unpack8(LD16(r0 - 1, 0), a); unpack8(LD16(r0 - 1, 2), b);
#pragma unroll
        for (int j = 0; j < 8; ++j) vp[j] = a[j] * b[j]; }
    { unpack8(LD16(r0, 0), a); unpack8(LD16(r0, 2), b);
#pragma unroll
      for (int j = 0; j < 8; ++j) vc[j] = a[j] * b[j]; }
#pragma unroll 2
    for (int i = 0; i < 8; ++i) { const int row = r0 + i;
#pragma unroll
        for (int j = 0; j < 8; ++j) vn[j] = 0.f;
        if (row + 1 < s1) { unpack8(LD16(row + 1, 0), a); unpack8(LD16(row + 1, 2), b);
#pragma unroll
            for (int j = 0; j < 8; ++j) vn[j] = a[j] * b[j]; }
        unpack8(LD16(row, 1), a); unpack8(LD16(row, 3), b);
        float y[8];
#pragma unroll
        for (int j = 0; j < 8; ++j) y[j] = silu_f(b[j]) * a[j] * (w0[j] * vp[j] + w1[j] * vc[j] + w2[j] * vn[j]);
        u32x4 w; w.x = pk2(y[0], y[1]); w.y = pk2(y[2], y[3]); w.z = pk2(y[4], y[5]); w.w = pk2(y[6], y[7]);
        *(u32x4*)(Y + (size_t)row * DM + ch0) = w;
#pragma unroll
        for (int j = 0; j < 8; ++j) { vp[j] = vc[j]; vc[j] = vn[j]; } }
#undef LD16
}

__device__ __forceinline__ void pool_item(const Params& p, int l, int rt, int g, LAS unsigned char* lds) {
    const int tid = otid(), R0 = rt * 64; int s0, s1; seq_bounds(R0, s0, s1);
    const bf16_t* P = (const bf16_t*)(p.ws + OFF_P); bf16_t* Y = (bf16_t*)(p.ws + OFF_HY);
    LAS bf16_t* ut = (LAS bf16_t*)lds;
    LAS bf16_t* dt = ut + 80 * 136;
    for (int c = tid; c < 1280; c += NTHREADS) { const int row = c >> 4, ch = c & 15, grow = R0 - 8 + row;
        u32x4 v = (u32x4){0u, 0u, 0u, 0u}; if (grow >= s0 && grow < s1) v = *(const u32x4*)(P + (size_t)grow * DIN + C_PU + g * 128 + ch * 8);
        *(LAS u32x4*)(ut + row * 136 + ch * 8) = v; }
    __syncthreads();
    { const int cp = tid & 63, rg = tid >> 6, hw = 1 << g, t0 = R0 + rg * 8;
#define LDU(lrow) (*(const LAS unsigned*)(ut + (lrow) * 136 + 2 * cp))
      float a0 = 0.f, a1 = 0.f;
      for (int j = -hw; j < hw; ++j) { const unsigned u = LDU(rg * 8 + 8 + j); a0 += bflo(u); a1 += bfhi(u); }
#pragma unroll
      for (int i = 0; i < 8; ++i) { const int t = t0 + i, lr = rg * 8 + 8 + i; const int lo_t = (t - hw < s0) ? s0 : t - hw, hi_t = (t + hw > s1) ? s1 : t + hw;
          const float inv = 1.f / (float)(hi_t - lo_t); const unsigned u = LDU(lr);
          *(LAS unsigned*)(dt + (rg * 8 + i) * 136 + 2 * cp) = pk2(a0 * inv - bflo(u), a1 * inv - bfhi(u));
          const unsigned un = LDU(lr + hw), uo = LDU(lr - hw);
          a0 += bflo(un) - bflo(uo); a1 += bfhi(un) - bfhi(uo); }
#undef LDU
    }
    __syncthreads();
    { const int wid = tid >> 6, lane = tid & 63, mt = wid & 3, nh = wid >> 2, fr = lane & 15, fq = lane >> 4;
      const bf16_t* PWT = (const bf16_t*)(p.ws + OFF_PWT) + (size_t)(l * 4 + g) * 128 * 128;
      f32x4 acc[4];
#pragma unroll
      for (int n = 0; n < 4; ++n) acc[n] = (f32x4){0.f, 0.f, 0.f, 0.f};
#pragma unroll
      for (int ks = 0; ks < 4; ++ks) { const bf16x8 a = *(const LAS bf16x8*)(dt + (mt * 16 + fr) * 136 + ks * 32 + fq * 8);
#pragma unroll
          for (int n = 0; n < 4; ++n) { const bf16x8 b = *(const bf16x8*)(PWT + (size_t)(nh * 64 + n * 16 + fr) * 128 + ks * 32 + fq * 8);
              acc[n] = __builtin_amdgcn_mfma_f32_16x16x32_bf16(a, b, acc[n], 0, 0, 0); } }
#pragma unroll
      for (int n = 0; n < 4; ++n)
#pragma unroll
          for (int j = 0; j < 4; ++j) { const int row = R0 + mt * 16 + 4 * fq + j, col = g * 128 + nh * 64 + n * 16 + fr;
              const float pg = bf2f(P[(size_t)row * DIN + C_PG + col]);
              const float y = silu_f(pg) * p.pool_scale[l * 512 + col] * acc[n][j];
              Y[(size_t)row * DM + 1536 + col] = (bf16_t)(pk2(y, 0.f) & 0xffffu); } }
    __syncthreads();
}

__device__ __forceinline__ void phase_mix(const Params& p, int l, LAS unsigned char* lds) {
    const int G = gridDim.x, blk = blockIdx.x, lane = otid() & 63;
    const float lam_init = (l == 0) ? 0.2f : 0.35550906759096935f;
    float lam;
    { const float a = p.lq1[l * 64 + lane] * p.lk1[l * 64 + lane], b = p.lq2[l * 64 + lane] * p.lk2[l * 64 + lane];
      lam = __expf(wave_sum(a)) - __expf(wave_sum(b)) + lam_init; }
    const int nrt = (l == 0) ? MROWS / 64 : NLAT / 64;
    const int n_conv = nrt, n_pool = nrt * 4, n_cattn = (l == 0) ? 32 : 0;
#ifndef NO_CONV
    for (int it = blk; it < n_conv; it += G) conv_item(p, l, it);
#endif
#ifndef NO_POOL
    for (int it = blk; it < n_pool; it += G) pool_item(p, l, it >> 2, it & 3, lds);
#endif
#ifdef PROBE_CP2
    for (int it = blk; it < n_conv; it += G) conv_item(p, l, it);
    for (int it = blk; it < n_pool; it += G) pool_item(p, l, it >> 2, it & 3, lds);
#endif
#ifndef NO_LATTN
    for (int u = blk; u < 512 + n_cattn; u += G) {
        int h, qrow0, crow0, lrow0, NT;
        if (u < 512) {
            int bh, qb;
            if (G == 256) { const int i = u >> 8, xcd = blk & 7, j = blk >> 3; bh = xcd * 4 + i * 2 + (j >> 4); qb = j & 15; }
            else { bh = u >> 4; qb = u & 15; }
            const int b = bh >> 3; h = bh & 7; qrow0 = b * SEQ + qb * 256; crow0 = NLAT + b * CTXL; lrow0 = b * SEQ; NT = 68;
        } else { const int q = u - 512, b = q >> 3; h = q & 7; qrow0 = NLAT + b * CTXL; crow0 = qrow0; lrow0 = qrow0; NT = 4; }
        att::attn_unit<0>(p, l, h, qrow0, crow0, lrow0, 4, NT, lam, 1.f - lam_init, (LAS char*)lds, (bf16_t*)(p.ws + OFF_HY));
    }
#endif
#ifdef PROBE_ATT
    if (l == 0) for (int u = blk; u < 512; u += G) {
        int bh, qb; if (G == 256) { const int i = u >> 8, xcd = blk & 7, j = blk >> 3; bh = xcd * 4 + i * 2 + (j >> 4); qb = j & 15; } else { bh = u >> 4; qb = u & 15; }
        const int b = bh >> 3, h = bh & 7;
        att::attn_unit<PROBE_ATT - 1>(p, l, h, b * SEQ + qb * 256, NLAT + b * CTXL, b * SEQ, 4, 68, lam, 1.f - lam_init, (LAS char*)lds, (bf16_t*)(p.ws + WS_END));
    }
#endif
    __syncthreads();
}

__device__ __forceinline__ void phase_ln(const Params& p, int l, bool final) {
    const int G = gridDim.x, tid = otid(), wid = tid >> 6, lane = tid & 63;
    const int nrows = final ? NLAT : MROWS;
    const float* MODF = (const float*)(p.ws + OFF_MODF); bf16_t* H = (bf16_t*)(p.ws + OFF_HY);
    const float* lg = p.ln_g + l * DM; const float* lb = p.ln_b + l * DM;
    for (int row = blockIdx.x * 8 + wid; row < nrows; row += G * 8) {
        const bool lat = row < NLAT;
        float* src = lat ? p.out + (size_t)row * DM : (float*)(p.ws + OFF_ZC) + (size_t)(row - NLAT) * DM;
        f32x4 v[8]; float s = 0.f;
#pragma unroll
        for (int i = 0; i < 8; ++i) { v[i] = *(const f32x4*)(src + (i * 64 + lane) * 4); s += (v[i][0] + v[i][1]) + (v[i][2] + v[i][3]); }
        const float mean = wave_sum(s) * (1.f / DM); float q = 0.f;
#pragma unroll
        for (int i = 0; i < 8; ++i) { const f32x4 d = v[i] - mean; q += (d[0] * d[0] + d[1] * d[1]) + (d[2] * d[2] + d[3] * d[3]); }
        const float rstd = __builtin_amdgcn_rsqf(wave_sum(q) * (1.f / DM) + LN_EPS);
        const int b = lat ? (row >> 12) : 4;
#pragma unroll
        for (int i = 0; i < 8; ++i) { const int col = (i * 64 + lane) * 4;
            const f32x4 xn = (v[i] - mean) * rstd * *(const f32x4*)(lg + col) + *(const f32x4*)(lb + col);
            if (lat) *(f32x4*)(src + col) = xn;
            if (!final) { const f32x4 sh = *(const f32x4*)(MODF + (size_t)(5 + b) * 6144 + col), sc = *(const f32x4*)(MODF + (size_t)(5 + b) * 6144 + 2048 + col);
                const f32x4 h = xn * (sc + 1.f) + sh; u32x2 w; w.x = pk2(h[0], h[1]); w.y = pk2(h[2], h[3]); *(u32x2*)(H + (size_t)row * DM + col) = w; } }
    }
}

#define XB_TMO      128
#define XB_XCNT(j)  (256  + 64 * (j))
#define XB_XSUB(j)  (1280 + 64 * (j))
#define XB_XGEN(j)  (2304 + 64 * (j))
#define XB_TOP      3328
#define XB_TOPGEN   3392
#define XCD_BAR_WORDS 3456
#define XB_SPIN_CAP (1u << 18)

__device__ __forceinline__ unsigned xb_ld(unsigned* p)              { return __hip_atomic_load(p, __ATOMIC_RELAXED, __HIP_MEMORY_SCOPE_AGENT); }
__device__ __forceinline__ unsigned xb_add(unsigned* p, unsigned v) { return __hip_atomic_fetch_add(p, v, __ATOMIC_RELAXED, __HIP_MEMORY_SCOPE_AGENT); }
__device__ __forceinline__ unsigned xb_xcc_id() { return (unsigned)__builtin_amdgcn_s_getreg((3 << 11) | 20) & 0xFu; }
#define XB_SPIN(cond, bar) do { unsigned _sp = 0; while (cond) { __builtin_amdgcn_s_sleep(1); \
    if ((++_sp & 255u) == 0u) { if (xb_ld(&(bar)[XB_TMO])) break; if (_sp > XB_SPIN_CAP) { atomicAdd(&(bar)[XB_TMO], 1u); break; } } } } while (0)

struct XcdBarrier {
    unsigned* bar; unsigned x;
    volatile LAS unsigned* st;
};

__device__ __forceinline__ XcdBarrier xcd_barrier_post(unsigned* bar, volatile LAS unsigned* st) {
    XcdBarrier b; b.bar = bar; b.x = xb_xcc_id(); b.st = st;
    if (threadIdx.x == 0) (void)xb_add(&bar[XB_XCNT(b.x)], 1u);
    return b;
}
__device__ __forceinline__ void xcd_barrier_complete(unsigned* bar, unsigned x, unsigned& nloc, unsigned& nx) {
    const unsigned G = gridDim.x * gridDim.y * gridDim.z;
    unsigned sum, cnt, mine, sp = 0u;
    for (;;) {
        sum = 0u; cnt = 0u; mine = 0u;
#pragma unroll
        for (unsigned j = 0; j < 16; ++j) { const unsigned c = xb_ld(&bar[XB_XCNT(j)]); sum += c; cnt += (c > 0u) ? 1u : 0u; mine = (j == x) ? c : mine; }
        if (sum == G) break;
        __builtin_amdgcn_s_sleep(1);
        if ((++sp & 255u) == 0u) { if (xb_ld(&bar[XB_TMO])) break; if (sp > XB_SPIN_CAP) { atomicAdd(&bar[XB_TMO], 1u); break; } }
    }
    nloc = mine > 0u ? mine : 1u; nx = cnt > 0u ? cnt : 1u;
}

__device__ __forceinline__ void xcd_barrier(const XcdBarrier& b) {
    asm volatile("s_waitcnt vmcnt(0)" ::: "memory");
    __syncthreads();
    if (threadIdx.x == 0) {
        unsigned* bar = b.bar;
        __builtin_amdgcn_s_waitcnt(0);
        unsigned nloc = b.st[0], nx = b.st[1];
        if (nloc == 0u) { xcd_barrier_complete(bar, b.x, nloc, nx); b.st[0] = nloc; b.st[1] = nx; }
        const unsigned old = xb_add(&bar[XB_XSUB(b.x)], 1u);
        const unsigned gen = old / nloc;
        if (old + 1u == (gen + 1u) * nloc) {
            __builtin_amdgcn_fence(__ATOMIC_RELEASE, "agent");
            asm volatile("s_waitcnt vmcnt(0)" ::: "memory");
            const unsigned og = xb_add(&bar[XB_TOP], 1u);
            const unsigned tg = og / nx;
            if (og + 1u == (tg + 1u) * nx) xb_add(&bar[XB_TOPGEN], 1u);
            else XB_SPIN(xb_ld(&bar[XB_TOPGEN]) == tg, bar);
            __builtin_amdgcn_fence(__ATOMIC_ACQUIRE, "agent");
            xb_add(&bar[XB_XGEN(b.x)], 1u);
            asm volatile("s_waitcnt vmcnt(0)" ::: "memory");
        } else {
            XB_SPIN(xb_ld(&bar[XB_XGEN(b.x)]) == gen, bar);
            __builtin_amdgcn_fence(__ATOMIC_ACQUIRE, "agent");
            asm volatile("s_waitcnt vmcnt(0)" ::: "memory");
        }
    }
    __syncthreads();
}

__global__ void __launch_bounds__(NTHREADS, 2) hybrid_fwd(Params p) {
    extern __shared__ __attribute__((aligned(16))) unsigned char lds_g[];
    LAS unsigned char* lds = (LAS unsigned char*)lds_g;
    cg::grid_group grid = cg::this_grid();
    { volatile LAS unsigned* st0 = (volatile LAS unsigned*)(lds + 147456 + 64); if (threadIdx.x < 2) st0[threadIdx.x] = 0u; }
    __syncthreads();
    XcdBarrier xbar = xcd_barrier_post((unsigned*)p.ws, (volatile LAS unsigned*)(lds + 147456 + 64));
#define GSYNC() xcd_barrier(xbar)
    const int G = gridDim.x;

#ifndef PH_MASK
#define PH_MASK 0xFF
#endif
    if constexpr (PH_MASK & 1) phase0(p, lds);
    grid.sync();
    if constexpr (PH_MASK & 2) phase_mod0(p);
    GSYNC();
#pragma unroll 1
    for (int l = 0; l < 2; ++l) {
        if constexpr (PH_MASK & 4) {
            pg8::Gemm g{(const bf16_t*)(p.ws + OFF_HY), (const bf16_t*)(p.ws + OFF_WTIN) + (size_t)l * DIN * DM, (l == 0) ? MROWS : NLAT, DIN, DM};
            OrderX S; S.base.init((l == 0) ? MROWS : NLAT, DIN, G, (int)blockIdx.x); S.nextra = (l == 0) ? 0 : 32; S.epm0 = 64; S.epn0 = 12; S.epnn = 8;
            EpiIn E{(bf16_t*)(p.ws + OFF_P), (const float*)(p.ws + OFF_ROPE)};
            pg8::gemm_phase<EpiIn, OrderX, true, true>(lds, g, S, E);
        }
        GSYNC();
        if constexpr (PH_MASK & 8) phase_mix(p, l, lds);
#ifdef PROBE_MIX2
        GSYNC(); phase_mix(p, l, lds);
#endif
        GSYNC();
        if constexpr (PH_MASK & 16) {
            pg8::Gemm g{(const bf16_t*)(p.ws + OFF_HY), (const bf16_t*)(p.ws + OFF_WTOUT) + (size_t)l * DM * DM, (l == 0) ? MROWS : NLAT, DM, DM};
            OrderX S; S.base.init((l == 0) ? MROWS : NLAT, DM, G, (int)blockIdx.x); S.nextra = 0; S.epm0 = 0; S.epn0 = 0; S.epnn = 1;
            EpiOut E{(l == 0) ? p.x : p.out, p.ctx, p.out, (float*)(p.ws + OFF_ZC), (const float*)(p.ws + OFF_MODF) + (size_t)l * 5 * 6144 + 4096};
            pg8::gemm_phase<EpiOut, OrderX, true, true>(lds, g, S, E);
        }
        GSYNC();
        if constexpr (PH_MASK & 32) phase_ln(p, l, l == 1);
        if (l == 0) GSYNC();
    }
}

extern "C" void kernel_launch(void* const* d_in, const int* in_sizes, int n_in, void* d_out, int out_size, void* d_ws, size_t ws_size, hipStream_t stream) {
    static int grid_blocks = 0;
    if (grid_blocks == 0) {
        if (n_in != 18 || in_sizes[0] != NLAT * DM || out_size != NLAT * DM || ws_size < WS_END) {
            fprintf(stderr, "kernel_launch: shape/workspace mismatch: n_in %d in0 %d out %d ws %zu (need %zu)\n", n_in, n_in > 0 ? in_sizes[0] : -1, out_size, ws_size, (size_t)WS_END); grid_blocks = -1; return; }
        int dev = 0, cus = 0, per_cu = 0;
        hipGetDevice(&dev); hipDeviceGetAttribute(&cus, hipDeviceAttributeMultiprocessorCount, dev);
        if (hipFuncSetAttribute((const void*)hybrid_fwd, hipFuncAttributeMaxDynamicSharedMemorySize, LDS_BYTES) != hipSuccess) { fprintf(stderr, "kernel_launch: hipFuncSetAttribute failed\n"); grid_blocks = -1; return; }
        if (hipOccupancyMaxActiveBlocksPerMultiprocessor(&per_cu, (const void*)hybrid_fwd, NTHREADS, LDS_BYTES) != hipSuccess || per_cu < 1) { fprintf(stderr, "kernel_launch: occupancy query gave %d\n", per_cu); per_cu = 1; }
        (void)hipGetLastError();
        grid_blocks = cus * 1;
        if (grid_blocks > 256) grid_blocks = 256;
    }
    if (grid_blocks < 0) return;
    Params p{};
    p.x = (const float*)d_in[0]; p.c = (const float*)d_in[1]; p.ctx = (const float*)d_in[2]; p.c_ctx = (const float*)d_in[3]; p.w_mod = (const float*)d_in[4]; p.b_mod = (const float*)d_in[5];
    p.w_in = (const float*)d_in[6]; p.conv_w = (const float*)d_in[7]; p.lq1 = (const float*)d_in[8]; p.lk1 = (const float*)d_in[9]; p.lq2 = (const float*)d_in[10]; p.lk2 = (const float*)d_in[11];
    p.subln_g = (const float*)d_in[12]; p.pool_w = (const float*)d_in[13]; p.pool_scale = (const float*)d_in[14]; p.w_out = (const float*)d_in[15]; p.ln_g = (const float*)d_in[16]; p.ln_b = (const float*)d_in[17];
    p.out = (float*)d_out; p.ws = (unsigned char*)d_ws;
    if (hipMemsetAsync(d_ws, 0, 16384, stream) != hipSuccess) { fprintf(stderr, "kernel_launch: hipMemsetAsync failed\n"); return; }
    void* args[] = {&p};
    const hipError_t e = hipLaunchCooperativeKernel((const void*)hybrid_fwd, dim3(grid_blocks), dim3(NTHREADS), args, LDS_BYTES, stream);
    if (e != hipSuccess) fprintf(stderr, "kernel_launch: cooperative launch failed: %s (grid %d)\n", hipGetErrorString(e), grid_blocks);
}
```

```cpp
#include <hip/hip_runtime.h>
#include <hip/hip_cooperative_groups.h>
#include <cstdio>
#include <cstdint>
namespace cg = cooperative_groups;
__device__ __forceinline__ int otid() { int t = threadIdx.x; asm volatile("" : "+v"(t)); return t; }
namespace pg8 {
#define PG8_LAS __attribute__((address_space(3)))
typedef unsigned short bf16_t;
typedef short bf16x8 __attribute__((ext_vector_type(8)));
typedef float f32x4 __attribute__((ext_vector_type(4)));
typedef unsigned u32x4 __attribute__((ext_vector_type(4)));
constexpr int BM = 256, BK = 64, HALF = 128, HTB = HALF * BK * 2  , STAGE_BYTES = 8 * HTB, NXCD = 8, WGM = 8;

__host__ __device__ __forceinline__ int lds_byte(int r, int c) { const int st = (r >> 4) * 2 + (c >> 5), rr = r & 15, cc = c & 31, ob = rr * 64 + cc * 2; return st * 1024 + (ob ^ (((ob >> 9) & 1) << 5)); }
__host__ __device__ __forceinline__ void stage_rc(int b, int& R, int& C) { const int st = b / 1024, sb = b % 1024, swz = sb ^ (((sb >> 9) & 1) << 5); R = (st >> 1) * 16 + swz / 64; C = (st & 1) * 32 + (swz % 64) / 2; }
__host__ __device__ __forceinline__ int perm32(int rho) { const int n = rho >> 4, i = rho & 15; return 8 * (i >> 2) + 4 * n + (i & 3); }

struct Unit { int pm, pn; };
struct Gemm { const bf16_t* A; const bf16_t* Bt; int M, N, K; };

struct StaticOrder {
    int nM, nN, nwg, G, c;
    __host__ __device__ void init(int M, int N, int G_, int c_) { nM = M / BM; nN = N / BM; nwg = nM * nN; G = G_; c = c_; }
    __host__ __device__ bool next(int i, Unit& u) const {
        const long L = (long)i * G + c; if (L >= nwg) return false;
        int wgid = (int)L; { const int q = nwg / NXCD, r = nwg % NXCD, xcd = wgid % NXCD, off = wgid / NXCD; wgid = (xcd < r ? xcd * (q + 1) : r * (q + 1) + (xcd - r) * q) + off; }
        const int nig = WGM * nN, gid = wgid / nig, fm = gid * WGM, gsz = (nM - fm) < WGM ? (nM - fm) : WGM;
        u.pm = fm + ((wgid % nig) % gsz); u.pn = (wgid % nig) / gsz; return true;
    }
    __device__ __forceinline__ void a_ready(const Unit&) const {}
    __device__ __forceinline__ void done(const Unit&) const {}
};

__device__ __forceinline__ unsigned cvt_pk_bf16(float lo, float hi) { unsigned r; asm volatile("v_cvt_pk_bf16_f32 %0, %1, %2" : "=v"(r) : "v"(lo), "v"(hi)); return r; }

template <class Epi, class Sched, bool ALIGN_EPI = false, bool SP2 = false>
__device__ __forceinline__ void gemm_phase(PG8_LAS unsigned char* lds, const Gemm g, const Sched& S, const Epi& E) {
    const int tid = otid(), wid = __builtin_amdgcn_readfirstlane(tid >> 6), lane = tid & 63, wr = wid >> 2, wc = wid & 3, fr = lane & 15, fq = lane >> 4;
    const int K = g.K, nt = K / BK;
    unsigned voffA[2], voffB[2];
#pragma unroll
    for (int i = 0; i < 2; ++i) { int R, C; stage_rc(tid * 16 + i * 8192, R, C); const int Rb = Epi::PERM ? ((R & ~31) + perm32(R & 31)) : R;
        voffA[i] = (unsigned)(R * K + C) * 2u; voffB[i] = (unsigned)(Rb * K + C) * 2u; }
    const size_t kstep = (size_t)(BK * 2);
    const size_t hstep = (size_t)HALF * K * 2;
    const size_t tstep = 2 * hstep;
    const unsigned ldsw = (unsigned)wid * 1024u;
    const int aoff = lds_byte(wr * 64 + fr, fq * 8), boff = lds_byte(wc * 32 + fr, fq * 8);
#define PG8_SA(b, h) (((b) * 2 + (h)) * HTB)
#define PG8_SB(b, h) ((4 + (b) * 2 + (h)) * HTB)
#define PG8_STAGE(bufoff, gbase, voff) do { _Pragma("unroll") for (int _i = 0; _i < 2; ++_i) \
        __builtin_amdgcn_global_load_lds((const unsigned*)((const char*)(gbase) + (voff)[_i]), (PG8_LAS unsigned*)(lds + (bufoff) + ldsw + _i * 8192), 16, 0, 0); } while (0)
#define PG8_LDA(dst, b, h) do { _Pragma("unroll") for (int m = 0; m < 4; ++m) _Pragma("unroll") for (int k = 0; k < 2; ++k) dst[m][k] = *(const PG8_LAS bf16x8*)(lds + PG8_SA(b, h) + aoff + m * 2048 + k * 1024); } while (0)
#define PG8_LDB(dst, b, h) do { _Pragma("unroll") for (int n = 0; n < 2; ++n) _Pragma("unroll") for (int k = 0; k < 2; ++k) dst[n][k] = *(const PG8_LAS bf16x8*)(lds + PG8_SB(b, h) + boff + n * 2048 + k * 1024); } while (0)
#define PG8_MMA(ai, bj, At, Bt) do { __builtin_amdgcn_s_setprio(1); _Pragma("unroll") for (int m = 0; m < 4; ++m) _Pragma("unroll") for (int n = 0; n < 2; ++n) _Pragma("unroll") for (int k = 0; k < 2; ++k) \
        acc[ai][bj][m][n] = __builtin_amdgcn_mfma_f32_16x16x32_bf16(Bt[n][k], At[m][k], acc[ai][bj][m][n], 0, 0, 0); __builtin_amdgcn_s_setprio(0); } while (0)
#define PG8_WAIT_V(n) asm volatile("s_waitcnt vmcnt(" #n ")" ::: "memory")
#define PG8_WAIT_L(n) asm volatile("s_waitcnt lgkmcnt(" #n ")" ::: "memory")
#define PG8_BAR __builtin_amdgcn_s_barrier()
#define PG8_SCHED __builtin_amdgcn_sched_barrier(0)
    Unit cur, nxt; int ui = 0;
    if (!S.next(0, cur)) return;
    f32x4 acc[2][2][4][2];
#pragma unroll
    for (int a = 0; a < 2; ++a)
#pragma unroll
        for (int b = 0; b < 2; ++b)
#pragma unroll
            for (int m = 0; m < 4; ++m)
#pragma unroll
                for (int n = 0; n < 2; ++n) acc[a][b][m][n] = (f32x4){0.f, 0.f, 0.f, 0.f};
    bf16x8 At[4][2], B0[2][2], B1[2][2];
    const char* cA = (const char*)g.A + (size_t)cur.pm * tstep; const char* cB = (const char*)g.Bt + (size_t)cur.pn * tstep;
    S.a_ready(cur);
    if constexpr (SP2) {
        PG8_STAGE(PG8_SB(0, 0), cB, voffB); PG8_STAGE(PG8_SB(0, 1), cB + hstep, voffB); PG8_STAGE(PG8_SA(0, 0), cA, voffA); PG8_STAGE(PG8_SA(0, 1), cA + hstep, voffA);
        if (wr == 1) PG8_BAR;
        PG8_WAIT_V(2); PG8_BAR;
        PG8_STAGE(PG8_SB(1, 0), cB + kstep, voffB); PG8_STAGE(PG8_SA(1, 0), cA + kstep, voffA); PG8_STAGE(PG8_SB(1, 1), cB + hstep + kstep, voffB);
        PG8_WAIT_V(6); PG8_BAR;
    } else {
        PG8_STAGE(PG8_SB(0, 0), cB, voffB); PG8_STAGE(PG8_SA(0, 0), cA, voffA); PG8_STAGE(PG8_SB(0, 1), cB + hstep, voffB); PG8_STAGE(PG8_SA(0, 1), cA + hstep, voffA);
        if (wr == 1) PG8_BAR;
        PG8_WAIT_V(4); PG8_BAR;
        PG8_STAGE(PG8_SB(1, 0), cB + kstep, voffB); PG8_STAGE(PG8_SA(1, 0), cA + kstep, voffA); PG8_STAGE(PG8_SB(1, 1), cB + hstep + kstep, voffB);
        PG8_WAIT_V(6); PG8_BAR;
    }
    for (;;) {
        const bool has_next = S.next(ui + 1, nxt);
        const char* nA = has_next ? (const char*)g.A + (size_t)nxt.pm * tstep : cA; const char* nB = has_next ? (const char*)g.Bt + (size_t)nxt.pn * tstep : cB;
        for (int t = 0; t < nt; t += 2) {
            const bool last = (t == nt - 2);
            const char* a1 = cA + (size_t)(t + 1) * kstep;
            const char* a2 = last ? nA : cA + (size_t)(t + 2) * kstep; const char* b2 = last ? nB : cB + (size_t)(t + 2) * kstep;
            const char* a3 = a2 + kstep; const char* b3 = b2 + kstep;
            if (last && has_next) S.a_ready(nxt);
            if constexpr (SP2) {
            PG8_LDB(B0, 0, 0); PG8_LDB(B1, 0, 1); PG8_SCHED; PG8_LDA(At, 0, 0); PG8_STAGE(PG8_SA(1, 1), a1 + hstep, voffA);
            PG8_WAIT_V(8); PG8_WAIT_L(0); PG8_BAR; PG8_MMA(0, 0, At, B0); PG8_MMA(0, 1, At, B1); PG8_BAR; PG8_SCHED;
            PG8_LDA(At, 0, 1); PG8_STAGE(PG8_SB(0, 0), b2, voffB); PG8_STAGE(PG8_SB(0, 1), b2 + hstep, voffB); PG8_STAGE(PG8_SA(0, 0), a2, voffA);
            PG8_WAIT_V(8); PG8_WAIT_L(0); PG8_BAR; PG8_MMA(1, 0, At, B0); PG8_MMA(1, 1, At, B1); PG8_BAR; PG8_SCHED;
            PG8_LDB(B0, 1, 0); PG8_LDB(B1, 1, 1); PG8_SCHED; PG8_LDA(At, 1, 0); PG8_STAGE(PG8_SA(0, 1), a2 + hstep, voffA);
            PG8_WAIT_V(8); PG8_WAIT_L(0); PG8_BAR; PG8_MMA(0, 0, At, B0); PG8_MMA(0, 1, At, B1); PG8_BAR; PG8_SCHED;
            PG8_LDA(At, 1, 1); PG8_STAGE(PG8_SB(1, 0), b3, voffB); PG8_STAGE(PG8_SB(1, 1), b3 + hstep, voffB); PG8_STAGE(PG8_SA(1, 0), a3, voffA);
            PG8_WAIT_V(8); PG8_WAIT_L(0); PG8_BAR; PG8_MMA(1, 0, At, B0); PG8_MMA(1, 1, At, B1); PG8_BAR; PG8_SCHED;
            } else {
            PG8_LDB(B0, 0, 0); PG8_SCHED; PG8_LDA(At, 0, 0); PG8_STAGE(PG8_SA(1, 1), a1 + hstep, voffA);
            PG8_WAIT_L(8); PG8_BAR; PG8_WAIT_L(0); PG8_MMA(0, 0, At, B0); PG8_BAR; PG8_SCHED;
            PG8_LDB(B1, 0, 1); PG8_STAGE(PG8_SB(0, 0), b2, voffB);
            PG8_BAR; PG8_WAIT_L(0); PG8_MMA(0, 1, At, B1); PG8_BAR;
            PG8_LDA(At, 0, 1); PG8_STAGE(PG8_SA(0, 0), a2, voffA);
            PG8_BAR; PG8_WAIT_L(0); PG8_MMA(1, 0, At, B0); PG8_BAR; PG8_SCHED;
            PG8_STAGE(PG8_SB(0, 1), b2 + hstep, voffB);
            PG8_WAIT_V(6); PG8_BAR; PG8_MMA(1, 1, At, B1); PG8_BAR;
            PG8_LDB(B0, 1, 0); PG8_SCHED; PG8_LDA(At, 1, 0); PG8_STAGE(PG8_SA(0, 1), a2 + hstep, voffA);
            PG8_WAIT_L(8); PG8_BAR; PG8_WAIT_L(0); PG8_MMA(0, 0, At, B0); PG8_BAR; PG8_SCHED;
            PG8_LDB(B1, 1, 1); PG8_STAGE(PG8_SB(1, 0), b3, voffB);
            PG8_BAR; PG8_WAIT_L(0); PG8_MMA(0, 1, At, B1); PG8_BAR;
            PG8_LDA(At, 1, 1); PG8_STAGE(PG8_SA(1, 0), a3, voffA);
            PG8_BAR; PG8_WAIT_L(0); PG8_MMA(1, 0, At, B0); PG8_BAR; PG8_SCHED;
            PG8_STAGE(PG8_SB(1, 1), b3 + hstep, voffB);
            PG8_WAIT_V(6); PG8_BAR; PG8_MMA(1, 1, At, B1); PG8_BAR;
            }
        }
        if constexpr (ALIGN_EPI) { if (wr == 0) PG8_BAR; }
        if constexpr (!Epi::AFTER_DRAIN) { E(acc, cur, wr, wc, fr, fq); S.done(cur); }
        if (!has_next) break;
#pragma unroll
        for (int a = 0; a < 2; ++a)
#pragma unroll
            for (int b = 0; b < 2; ++b)
#pragma unroll
                for (int m = 0; m < 4; ++m)
#pragma unroll
                    for (int n = 0; n < 2; ++n) acc[a][b][m][n] = (f32x4){0.f, 0.f, 0.f, 0.f};
        cur = nxt; cA = nA; cB = nB; ++ui;
        if constexpr (ALIGN_EPI) { if (wr == 1) PG8_BAR; }
    }
    PG8_WAIT_V(0);
    if constexpr (!ALIGN_EPI) { if (wr == 0) PG8_BAR; }
    PG8_BAR;
    if constexpr (Epi::AFTER_DRAIN) { E.fused(acc, cur, wr, wc, fr, fq, lds, wid, lane); S.done(cur); }
#undef PG8_SA
#undef PG8_SB
#undef PG8_STAGE
#undef PG8_LDA
#undef PG8_LDB
#undef PG8_MMA
#undef PG8_WAIT_V
#undef PG8_WAIT_L
#undef PG8_BAR
#undef PG8_SCHED
}
}

using pg8::bf16_t; using pg8::bf16x8; using pg8::f32x4; using pg8::u32x4;
typedef float f32x16 __attribute__((ext_vector_type(16)));
typedef short s16x4 __attribute__((ext_vector_type(4)));
typedef unsigned u32x2 __attribute__((ext_vector_type(2)));
#define LAS __attribute__((address_space(3)))

constexpr int DM = 2048, NB = 4, SEQ = 4096, CTXL = 256, NLAT = NB * SEQ, NCTX = NB * CTXL, MROWS = NLAT + NCTX, DIN = 7168;
constexpr int C_Q = 2048, C_K = 3072, C_V = 4096, C_AG = 5120, C_PU = 6144, C_PG = 6656;
constexpr float LN_EPS = 1e-5f, RMS_EPS = 1e-5f;
constexpr float ALPHA = 1.4142135623730951f;
constexpr float QSCALE = 0.125f * 1.4426950408889634f;
constexpr int NTHREADS = 512;
constexpr int LDS_BYTES = 147456 + 1024;

constexpr size_t OFF_WTIN = 1u << 20;
constexpr size_t OFF_WTOUT = OFF_WTIN + (size_t)2 * DIN * DM * 2;
constexpr size_t OFF_PWT = OFF_WTOUT + (size_t)2 * DM * DM * 2;
constexpr size_t OFF_MODP = OFF_PWT + 262144;
constexpr size_t OFF_MODF = OFF_MODP + 983040;
constexpr size_t OFF_ROPE = OFF_MODF + 245760;
constexpr size_t OFF_HY = OFF_ROPE + 8192;
constexpr size_t OFF_P = OFF_HY + (size_t)MROWS * DM * 2;
constexpr size_t OFF_ZC = OFF_P + (size_t)MROWS * DIN * 2;
constexpr size_t OFF_O1 = OFF_ZC + (size_t)NCTX * DM * 4;
constexpr size_t WS_END = OFF_O1 + (size_t)256 * 256 * 128 * 4;

struct Params {
    const float *x, *c, *ctx, *c_ctx, *w_mod, *b_mod, *w_in, *conv_w, *lq1, *lk1, *lq2, *lk2, *subln_g, *pool_w, *pool_scale, *w_out, *ln_g, *ln_b;
    float* out; unsigned char* ws;
};

__device__ __forceinline__ float silu_f(float v) { return v / (1.f + __expf(-v)); }
__device__ __forceinline__ float bf2f(unsigned short b) { return __uint_as_float(((unsigned)b) << 16); }
__device__ __forceinline__ float bflo(unsigned w) { return __uint_as_float(w << 16); }
__device__ __forceinline__ float bfhi(unsigned w) { return __uint_as_float(w & 0xffff0000u); }
__device__ __forceinline__ unsigned pk2(float lo, float hi) { return pg8::cvt_pk_bf16(lo, hi); }
__device__ __forceinline__ float wave_sum(float v) {
#pragma unroll
    for (int o = 32; o >= 1; o >>= 1) v += __shfl_xor(v, o);
    return v;
}

__device__ __forceinline__ int rope_src(int j) { const int part = j >> 5, jj = j & 31; return part * 32 + (jj & 1) * 16 + (jj >> 1); }

__device__ __forceinline__ void transpose_tile(const float* __restrict__ src, int K, int N, bf16_t* __restrict__ dst, int k0, int n0, bool permq, LAS float* tile) {
    const int tid = otid();
    { const int r = tid >> 4, c4 = (tid & 15) * 4;
#pragma unroll
      for (int i = 0; i < 2; ++i) { const int k = r + 32 * i; const f32x4 v = *(const f32x4*)(src + (size_t)(k0 + k) * N + n0 + c4);
          tile[k * 65 + c4 + 0] = v[0]; tile[k * 65 + c4 + 1] = v[1]; tile[k * 65 + c4 + 2] = v[2]; tile[k * 65 + c4 + 3] = v[3]; } }
    __syncthreads();
    { const int n = tid >> 3, kc = (tid & 7) * 8; const int ns = permq ? rope_src(n) : n;
      float f[8];
#pragma unroll
      for (int j = 0; j < 8; ++j) f[j] = tile[(kc + j) * 65 + ns];
      u32x4 w; w.x = pk2(f[0], f[1]); w.y = pk2(f[2], f[3]); w.z = pk2(f[4], f[5]); w.w = pk2(f[6], f[7]);
      *(u32x4*)(dst + (size_t)(n0 + n) * K + k0 + kc) = w; }
    __syncthreads();
}

__device__ __forceinline__ void gemv_item(const Params& p, int item, LAS float* lds) {
    const int l = item / 192, rem = item % 192, kq = rem / 48, cgp = rem % 48, tid = threadIdx.x;
    LAS float* s = lds; LAS float* red = lds + 2560;
    float* MODP = (float*)(p.ws + OFF_MODP);
#pragma unroll
    for (int r = 0; r < 5; ++r) { const int k = kq * 512 + tid; const float v = (r < 4) ? p.c[r * DM + k] : p.c_ctx[k]; s[r * 512 + tid] = silu_f(v); }
    __syncthreads();
    const int kl = tid >> 5, c4 = tid & 31;
    const float* W = p.w_mod + (size_t)l * DM * 6144 + (size_t)(kq * 512) * 6144 + cgp * 128 + c4 * 4;
    f32x4 acc[5];
#pragma unroll
    for (int r = 0; r < 5; ++r) acc[r] = (f32x4){0.f, 0.f, 0.f, 0.f};
#pragma unroll 4
    for (int i = 0; i < 32; ++i) { const int k = kl + 16 * i; const f32x4 w = *(const f32x4*)(W + (size_t)k * 6144);
#pragma unroll
        for (int r = 0; r < 5; ++r) { const float sv = s[r * 512 + k]; acc[r] += w * sv; } }
#pragma unroll
    for (int r = 0; r < 5; ++r) { LAS float* q = red + (kl * 5 + r) * 128 + c4 * 4; q[0] = acc[r][0]; q[1] = acc[r][1]; q[2] = acc[r][2]; q[3] = acc[r][3]; }
    __syncthreads();
    for (int o = tid; o < 640; o += NTHREADS) { const int r = o >> 7, cc = o & 127; float sum = 0.f;
#pragma unroll
        for (int k2 = 0; k2 < 16; ++k2) sum += red[(k2 * 5 + r) * 128 + cc];
        MODP[(size_t)((l * 4 + kq) * 5 + r) * 6144 + cgp * 128 + cc] = sum; }
    __syncthreads();
}

constexpr int N_GEMV = 384, N_TIN = 3584, N_TOUT = 1024, N_TPOOL = 16, N_TRANS = N_TIN + N_TOUT + N_TPOOL;
constexpr int IT_TIN = N_GEMV, IT_ROPE = IT_TIN + 2 * N_TRANS, N_ITEMS0 = IT_ROPE + 1;
__device__ __forceinline__ void transpose_item(const Params& p, int l, int q, LAS float* fl) {
    if (q < N_TIN) { const int tk = q / 112, tn = q % 112;
        transpose_tile(p.w_in + (size_t)l * DM * DIN, DM, DIN, (bf16_t*)(p.ws + OFF_WTIN) + (size_t)l * DIN * DM, tk * 64, tn * 64, (tn * 64 >= C_Q && tn * 64 < C_V), fl); }
    else if (q < N_TIN + N_TOUT) { const int t = q - N_TIN, tk = t / 32, tn = t % 32;
        transpose_tile(p.w_out + (size_t)l * DM * DM, DM, DM, (bf16_t*)(p.ws + OFF_WTOUT) + (size_t)l * DM * DM, tk * 64, tn * 64, false, fl); }
    else { const int t = q - N_TIN - N_TOUT, mtx = l * 4 + (t >> 2), tk = (t >> 1) & 1, tn = t & 1;
        transpose_tile(p.pool_w + (size_t)mtx * 128 * 128, 128, 128, (bf16_t*)(p.ws + OFF_PWT) + (size_t)mtx * 128 * 128, tk * 64, tn * 64, false, fl); }
}

__device__ __forceinline__ void phase0(const Params& p, LAS unsigned char* lds) {
    LAS float* fl = (LAS float*)lds;
    for (int it = blockIdx.x; it < N_ITEMS0; it += gridDim.x) {
        if (it < IT_TIN) gemv_item(p, it, fl);
        else if (it < IT_ROPE) { const int q = it - IT_TIN; transpose_item(p, q & 1, q >> 1, fl); }
        else { float* rope = (float*)(p.ws + OFF_ROPE);
            for (int e = otid(); e < 1024; e += NTHREADS) { const int pos = e >> 4, i = e & 15;
                const float inv = exp2f(-(float)i * 0.830482023721841f);
                const float ang = (float)pos * inv; float sn, cs; sincosf(ang, &sn, &cs);
                rope[2 * e] = cs; rope[2 * e + 1] = sn; } }
    }
}

__device__ __forceinline__ void phase_mod0(const Params& p) {
    const int tid = otid(), G = gridDim.x, blk = blockIdx.x;
    const float* MODP = (const float*)(p.ws + OFF_MODP); float* MODF = (float*)(p.ws + OFF_MODF);
    bf16_t* H = (bf16_t*)(p.ws + OFF_HY);
    for (int idx = blk * NTHREADS + tid; idx < 2 * 5 * 6144; idx += G * NTHREADS) {
        const int l = idx / 30720, rem = idx % 30720, r = rem / 6144, n = rem % 6144; float v = p.b_mod[l * 6144 + n];
#pragma unroll
        for (int kq = 0; kq < 4; ++kq) v += MODP[(size_t)((l * 4 + kq) * 5 + r) * 6144 + n];
        MODF[idx] = v; }
    const int per = (MROWS + G - 1) / G; int r0 = blk * per, r1 = r0 + per; if (r1 > MROWS) r1 = MROWS;
    const int col = 4 * tid;
    while (r0 < r1) {
        const int b = r0 < NLAT ? r0 / SEQ : 4; int rend = r0 < NLAT ? (b + 1) * SEQ : MROWS; if (rend > r1) rend = r1;
        f32x4 sh = *(const f32x4*)(p.b_mod + col), sc = *(const f32x4*)(p.b_mod + 2048 + col);
#pragma unroll
        for (int kq = 0; kq < 4; ++kq) { sh += *(const f32x4*)(MODP + (size_t)(kq * 5 + b) * 6144 + col); sc += *(const f32x4*)(MODP + (size_t)(kq * 5 + b) * 6144 + 2048 + col); }
        sc += 1.f;
#pragma unroll 4
        for (int row = r0; row < rend; ++row) {
            const float* src = row < NLAT ? p.x + (size_t)row * DM : p.ctx + (size_t)(row - NLAT) * DM;
            const f32x4 v = *(const f32x4*)(src + col); const f32x4 h = v * sc + sh;
            u32x2 w; w.x = pk2(h[0], h[1]); w.y = pk2(h[2], h[3]); *(u32x2*)(H + (size_t)row * DM + col) = w; }
        r0 = rend;
    }
}

struct OrderX {
    pg8::StaticOrder base; int nextra, epm0, epn0, epnn;
    __device__ __forceinline__ bool next(int i, pg8::Unit& u) const {
        const long L = (long)i * base.G + base.c; if (L < base.nwg) return base.next(i, u);
        const int e = (int)(L - base.nwg); if (e >= nextra) return false; u.pm = epm0 + e / epnn; u.pn = epn0 + e % epnn; return true; }
    __device__ __forceinline__ void a_ready(const pg8::Unit&) const {}
    __device__ __forceinline__ void done(const pg8::Unit&) const {}
};

struct EpiIn {
    static constexpr bool PERM = true, AFTER_DRAIN = false;
    bf16_t* P; const float* rope;
    __device__ __forceinline__ void operator()(const f32x4 (&acc)[2][2][4][2], const pg8::Unit& u, int wr, int wc, int fr, int fq) const {
        const bool isq = (u.pn >= 8 && u.pn < 12), isk = (u.pn >= 12 && u.pn < 16);
        const bool dorope = (isq || isk) && (u.pm < 64);
        const float qs = isq ? QSCALE : 1.f;
#pragma unroll
        for (int ai = 0; ai < 2; ++ai)
#pragma unroll
            for (int m = 0; m < 4; ++m) {
                const int row = u.pm * 256 + ai * 128 + wr * 64 + m * 16 + fr; const int t = row & 4095, prow = t >> 6, pcol = t & 63;
#pragma unroll
                for (int bj = 0; bj < 2; ++bj) {
                    const int col0 = u.pn * 256 + bj * 128 + wc * 32 + 8 * fq;
                    f32x4 v0 = acc[ai][bj][m][0], v1 = acc[ai][bj][m][1];
                    if (dorope) { const int part = (col0 >> 5) & 1, i0 = (col0 & 31) >> 1, pos = part ? pcol : prow; const float* rp = rope + (pos * 16 + i0) * 2;
                        const f32x4 c0 = *(const f32x4*)rp, c1 = *(const f32x4*)(rp + 4); float a, b;
                        a = v0[0]; b = v0[1]; v0[0] = a * c0[0] - b * c0[1]; v0[1] = a * c0[1] + b * c0[0];
                        a = v0[2]; b = v0[3]; v0[2] = a * c0[2] - b * c0[3]; v0[3] = a * c0[3] + b * c0[2];
                        a = v1[0]; b = v1[1]; v1[0] = a * c1[0] - b * c1[1]; v1[1] = a * c1[1] + b * c1[0];
                        a = v1[2]; b = v1[3]; v1[2] = a * c1[2] - b * c1[3]; v1[3] = a * c1[3] + b * c1[2]; }
                    v0 = v0 * qs; v1 = v1 * qs;
                    u32x4 w; w.x = pk2(v0[0], v0[1]); w.y = pk2(v0[2], v0[3]); w.z = pk2(v1[0], v1[1]); w.w = pk2(v1[2], v1[3]);
                    *(u32x4*)(P + (size_t)row * DIN + col0) = w; } }
    }
};

struct EpiOut {
    static constexpr bool PERM = true, AFTER_DRAIN = false;
    const float* xlat; const float* xctx; float* olat; float* octx; const float* gate;
    __device__ __forceinline__ void operator()(const f32x4 (&acc)[2][2][4][2], const pg8::Unit& u, int wr, int wc, int fr, int fq) const {
        const bool lat = u.pm < 64;
#pragma unroll
        for (int ai = 0; ai < 2; ++ai)
#pragma unroll
            for (int m = 0; m < 4; ++m) {
                const int row = u.pm * 256 + ai * 128 + wr * 64 + m * 16 + fr; const int b = lat ? (row >> 12) : 4;
                const float* xr = lat ? xlat + (size_t)row * DM : xctx + (size_t)(row - NLAT) * DM;
                float* orow = lat ? olat + (size_t)row * DM : octx + (size_t)(row - NLAT) * DM;
                const float* gr = gate + b * 6144;
#pragma unroll
                for (int bj = 0; bj < 2; ++bj) {
                    const int col0 = u.pn * 256 + bj * 128 + wc * 32 + 8 * fq;
                    const f32x4 g0 = *(const f32x4*)(gr + col0), g1 = *(const f32x4*)(gr + col0 + 4);
                    const f32x4 x0 = *(const f32x4*)(xr + col0), x1 = *(const f32x4*)(xr + col0 + 4);
                    const f32x4 z0 = x0 * ALPHA + g0 * acc[ai][bj][m][0], z1 = x1 * ALPHA + g1 * acc[ai][bj][m][1];
                    *(f32x4*)(orow + col0) = z0; *(f32x4*)(orow + col0 + 4) = z1; } }
    }
};

namespace att {
constexpr int SHM_V = 16384, SHM_K = 8192, NSLOT = 3;
constexpr int LDS_K = 0, LDS_V = NSLOT * SHM_K, LDS_WS = LDS_V + NSLOT * SHM_V, LDS_TOTAL = LDS_WS + 8 * 64 * 4;
constexpr float THRL = 8.f;
#define KSW(row, chunk) ((row) * 128 + ((((chunk) ^ (((row) >> 1) & 7))) << 4))
#define SBAR() __builtin_amdgcn_sched_barrier(0)
__device__ __forceinline__ int crow(int r, int hi) { return (r & 3) + 8 * (r >> 2) + 4 * hi; }
__device__ __forceinline__ unsigned cvtpk(float lo, float hi) { unsigned r; asm volatile("v_cvt_pk_bf16_f32 %0, %1, %2" : "=v"(r) : "v"(lo), "v"(hi)); return r; }

__device__ __forceinline__ float max3f(float a, float b, float c) { float r; asm("v_max3_f32 %0, %1, %2, %3" : "=v"(r) : "v"(a), "v"(b), "v"(c)); return r; }
template <bool FIRST, int VAR = 0>
__device__ __forceinline__ void partialSM(f32x16& p0, f32x16& p1, float& mref) {
    if (FIRST) {
        float pmax = max3f(p0[0], p0[1], p1[0]); pmax = max3f(pmax, p1[1], p0[2]);
#pragma unroll
        for (int r = 2; r < 16; r += 2) { pmax = max3f(pmax, p1[r], p1[r + 1]); if (r + 2 < 16) pmax = max3f(pmax, p0[r + 1], p0[r + 2]); else pmax = fmaxf(pmax, p0[r + 1]); }
        { auto rr = __builtin_amdgcn_permlane32_swap(__float_as_uint(pmax), __float_as_uint(pmax), false, false);
          pmax = fmaxf(__uint_as_float(rr[0]), __uint_as_float(rr[1])); }
        mref = __any(fabsf(pmax) > 40.f) ? pmax : 0.f;
    }
    if (__builtin_expect(__any(mref != 0.f), 0)) { const float mn = mref;
#pragma unroll
        for (int r = 0; r < 16; ++r) p0[r] -= mn; }
#pragma unroll
    for (int r = 0; r < 16; ++r) p0[r] = (VAR & 1) ? p0[r] * 0.001f : __builtin_amdgcn_exp2f(p0[r]);
}
template <int VAR = 0>
__device__ __forceinline__ float finishSM(f32x16& p0, f32x16& p1, float& mref, float& l_reg, bf16x8& pa0, bf16x8& pa1, bf16x8& pa2, bf16x8& pa3) {
    if (__builtin_expect(__any(mref != 0.f), 0)) { const float mn = mref;
#pragma unroll
        for (int r = 0; r < 16; ++r) p1[r] -= mn; }
#pragma unroll
    for (int r = 0; r < 16; ++r) p1[r] = (VAR & 1) ? p1[r] * 0.001f : __builtin_amdgcn_exp2f(p1[r]);
    float ps = 0;
#pragma unroll
    for (int r = 0; r < 16; ++r) ps += p0[r];
#pragma unroll
    for (int r = 0; r < 16; ++r) ps += p1[r];
    { auto rr = __builtin_amdgcn_permlane32_swap(__float_as_uint(ps), __float_as_uint(ps), false, false);
      ps = __uint_as_float(rr[0]) + __uint_as_float(rr[1]); }
    float f = 1.f;
    if (__builtin_expect(__any(ps > 16777216.f), 0)) {
        if (ps > 16777216.f) { const int e = ((__float_as_uint(ps) >> 23) & 0xff) - 127; f = __uint_as_float((unsigned)(127 - e) << 23); mref += (float)e; }
#pragma unroll
        for (int r = 0; r < 16; ++r) { p0[r] *= f; p1[r] *= f; }
        ps *= f; l_reg *= f;
    }
    l_reg += ps;
#define PK4(P, BASE, OUT) do { u32x4 w = {cvtpk(P[BASE + 0], P[BASE + 1]), cvtpk(P[BASE + 2], P[BASE + 3]), cvtpk(P[BASE + 4], P[BASE + 5]), cvtpk(P[BASE + 6], P[BASE + 7])}; \
    OUT = *reinterpret_cast<bf16x8*>(&w); } while (0)
    PK4(p0, 0, pa0); PK4(p0, 8, pa1); PK4(p1, 0, pa2); PK4(p1, 8, pa3);
#undef PK4
    return f;
}
__device__ __forceinline__ void qkt(f32x16& p0, f32x16& p1, const LAS char* Ks, const bf16x8* qr, int r32, int hi) {
#pragma unroll
    for (int d0 = 0; d0 < 4; ++d0) { const int ch = d0 * 2 + hi;
        bf16x8 b0 = *(const LAS bf16x8*)(Ks + KSW(r32, ch));
        bf16x8 b1 = *(const LAS bf16x8*)(Ks + KSW(32 + r32, ch));
        if (d0 == 0) { p0 = __builtin_amdgcn_mfma_f32_32x32x16_bf16(b0, qr[0], f32x16{}, 0, 0, 0); p1 = __builtin_amdgcn_mfma_f32_32x32x16_bf16(b1, qr[0], f32x16{}, 0, 0, 0); }
        else { p0 = __builtin_amdgcn_mfma_f32_32x32x16_bf16(b0, qr[d0], p0, 0, 0, 0); p1 = __builtin_amdgcn_mfma_f32_32x32x16_bf16(b1, qr[d0], p1, 0, 0, 0); } }
}
__device__ __forceinline__ int v_st(int k, int c) { const int kk = (k & ~0xC) | ((k & 4) << 1) | ((k & 8) >> 1); return ((kk >> 3) * 4 + (c >> 5)) * 512 + ((kk & 7) * 32 + (c & 31)) * 2; }
__device__ __forceinline__ int v_rd_base(int lane) { return ((lane & 3) << 3) | (((lane >> 2) & 3) << 6) | (((lane >> 4) & 1) << 5) | (((lane >> 5) & 1) << 8); }
constexpr int v_rd_off(int d0, int ks, int half) { return d0 * 512 + ks * 4096 + half * 2048; }
template <int OFF> __device__ __forceinline__ s16x4 tr_read(int vb) {
    s16x4 r; asm volatile("ds_read_b64_tr_b16 %0, %1 offset:%2" : "=&v"(r) : "v"(vb), "i"(OFF) : "memory"); return r;
}
#define RD8(KS, X) const s16x4 X##0 = tr_read<v_rd_off(0, KS, 0)>(vb), X##1 = tr_read<v_rd_off(0, KS, 1)>(vb), X##2 = tr_read<v_rd_off(1, KS, 0)>(vb), X##3 = tr_read<v_rd_off(1, KS, 1)>(vb), \
    X##4 = tr_read<v_rd_off(2, KS, 0)>(vb), X##5 = tr_read<v_rd_off(2, KS, 1)>(vb), X##6 = tr_read<v_rd_off(3, KS, 0)>(vb), X##7 = tr_read<v_rd_off(3, KS, 1)>(vb)
#define WDEP(N, X) s16x4 X##w0 = X##0, X##w1 = X##1, X##w2 = X##2, X##w3 = X##3, X##w4 = X##4, X##w5 = X##5, X##w6 = X##6, X##w7 = X##7; \
    asm volatile("s_waitcnt lgkmcnt(" #N ")" : "+v"(X##w0), "+v"(X##w1), "+v"(X##w2), "+v"(X##w3), "+v"(X##w4), "+v"(X##w5), "+v"(X##w6), "+v"(X##w7) :: "memory")
#define PKV(L, H) (bf16x8){L[0], L[1], L[2], L[3], H[0], H[1], H[2], H[3]}
#define MM4(pa, X) o[0] = __builtin_amdgcn_mfma_f32_32x32x16_bf16(pa, PKV(X##w0, X##w1), o[0], 0, 0, 0); o[1] = __builtin_amdgcn_mfma_f32_32x32x16_bf16(pa, PKV(X##w2, X##w3), o[1], 0, 0, 0); \
    o[2] = __builtin_amdgcn_mfma_f32_32x32x16_bf16(pa, PKV(X##w4, X##w5), o[2], 0, 0, 0); o[3] = __builtin_amdgcn_mfma_f32_32x32x16_bf16(pa, PKV(X##w6, X##w7), o[3], 0, 0, 0)
__device__ __forceinline__ void pv_d0(f32x16* o, int vb, bf16x8 pa0, bf16x8 pa1, bf16x8 pa2, bf16x8 pa3) {
    RD8(0, a);
    RD8(1, b); WDEP(8, a); MM4(pa0, a);
    RD8(2, c); WDEP(8, b); MM4(pa1, b);
    RD8(3, d); WDEP(8, c); MM4(pa2, c);
    WDEP(0, d); MM4(pa3, d);
}
#undef RD8
#undef WDEP
#undef PKV
#undef MM4

template <int VAR>
__device__ __forceinline__ void attn_map(const bf16_t* __restrict__ Qw, const bf16_t* __restrict__ Kc, const bf16_t* __restrict__ Vc, int ctx_row0, int lat_row0, int nct, int NT,
                                         LAS char* lds, f32x16 (&o)[4], float& l_out) {
    const int tid = otid(), wid = __builtin_amdgcn_readfirstlane(tid >> 6), lane = tid & 63, r32 = lane & 31, hi = lane >> 5;
    LAS char* V_lds = lds + LDS_V; LAS char* K_lds = lds + LDS_K;
    LAS float* ws = (LAS float*)(lds + LDS_WS) + wid * 64; LAS float* al_l = ws + 32;
    float m_reg = 0.f, l_reg = 0;
#pragma unroll
    for (int d = 0; d < 4; ++d) o[d] = f32x16{};
    const int krow = wid * 8 + (lane >> 3), kchunk = (lane & 7) ^ ((krow >> 1) & 7);
    const bf16_t* ksrc = Kc + (size_t)krow * DIN + kchunk * 8;
    const int kkey = wid * 8 + ((lane & 31) >> 2);
    const bf16_t* vsrc0 = Vc + (size_t)kkey * DIN + hi * 32 + (lane & 3) * 8;
    const int vb0 = (int)(uintptr_t)V_lds + v_rd_base(lane);
#define KROW(t) (((t) < nct) ? (ctx_row0 + (t) * 64) : (lat_row0 + ((t) - nct) * 64))
#define DMA(t, slot) do { const size_t ro_ = (size_t)KROW(t) * DIN; \
    __builtin_amdgcn_global_load_lds((const unsigned*)(ksrc + ro_), (LAS unsigned*)(K_lds + (slot) * SHM_K + wid * 1024), 16, 0, 0); \
    __builtin_amdgcn_global_load_lds((const unsigned*)(vsrc0 + ro_), (LAS unsigned*)(V_lds + (slot) * SHM_V + wid * 2048), 16, 0, 0); \
    __builtin_amdgcn_global_load_lds((const unsigned*)(vsrc0 + ro_ + 64), (LAS unsigned*)(V_lds + (slot) * SHM_V + wid * 2048 + 1024), 16, 0, 0); } while (0)
#define WAIT_BAR(N) asm volatile("s_waitcnt vmcnt(" #N ") lgkmcnt(0)\n\ts_barrier" ::: "memory")
#define RESC(a) do { if (__any((a) < 1.f)) { if (hi == 0) al_l[r32] = (a); asm volatile("s_waitcnt lgkmcnt(0)" ::: "memory"); \
    _Pragma("unroll") for (int d = 0; d < 4; ++d) _Pragma("unroll") for (int r = 0; r < 16; ++r) o[d][r] *= al_l[crow(r, hi)]; } } while (0)
#define STEP(C0, C1, alC, P0, P1, alP, t, GD) do { WAIT_BAR(0); \
    if (GD && !(VAR & 2)) { DMA((t) + 1, sn); } SBAR(); \
    qkt(C0, C1, K_lds + sc_ * SHM_K, qr, r32, hi); \
    { const float f_ = finishSM<VAR>(P0, P1, m_reg, l_reg, pa0, pa1, pa2, pa3); RESC(f_); } SBAR(); \
    if (!(VAR & 4)) pv_d0(o, vb0 + sp * SHM_V, pa0, pa1, pa2, pa3); partialSM<false, VAR>(C0, C1, m_reg); \
    sp = sc_; sc_ = sn; sn = (sn == NSLOT - 1) ? 0 : sn + 1; } while (0)
    f32x16 pA0, pA1, pB0, pB1; const float alA = 1.f, alB = 1.f; bf16x8 pa0, pa1, pa2, pa3; (void)alA; (void)alB;
    WAIT_BAR(0);
    bf16x8 qr[4];
#pragma unroll
    for (int d0 = 0; d0 < 4; ++d0) qr[d0] = *reinterpret_cast<const bf16x8*>(Qw + d0 * 16);
    if (!(VAR & 2)) { DMA(0, 0); DMA(1, 1); }
    WAIT_BAR(3);
    qkt(pA0, pA1, K_lds, qr, r32, hi); partialSM<true, VAR>(pA0, pA1, m_reg);
    int sp = 0, sc_ = 1, sn = 2;
    for (int j = 1; j + 1 < NT; j += 2) {
        STEP(pB0, pB1, alB, pA0, pA1, alA, j, true);
        STEP(pA0, pA1, alA, pB0, pB1, alB, j + 1, true);
    }
    STEP(pB0, pB1, alB, pA0, pA1, alA, NT - 1, false);
    { const float f_ = finishSM<VAR>(pB0, pB1, m_reg, l_reg, pa0, pa1, pa2, pa3); RESC(f_); } SBAR();
    pv_d0(o, vb0 + sp * SHM_V, pa0, pa1, pa2, pa3);
    l_out = l_reg;
#undef KROW
#undef DMA
#undef WAIT_BAR
#undef RESC
#undef STEP
}

constexpr int LDS_OB = 0, LDS_OA = 81920, LDS_ATT_END = LDS_OA + 65536;
static_assert(LDS_TOTAL <= LDS_OA, "attention LDS map");
template <int VAR = 0>
__device__ __forceinline__ void attn_unit(const Params& p, int l, int h, int qrow0, int ctx_row0, int lat_row0, int nct, int NT, float lam, float oml, LAS char* lds, bf16_t* Y) {
    const int tid = otid(), wid = tid >> 6, lane = tid & 63, r32 = lane & 31, hi = lane >> 5;
    const bf16_t* P = (const bf16_t*)(p.ws + OFF_P);
    LAS float* li_l = (LAS float*)(lds + LDS_WS) + wid * 64;
    f32x16 o[4]; float l_reg;
#ifndef MPN
#define MPN 2
#endif
#pragma unroll
    for (int mp = 0; mp < MPN; ++mp) {
        const bf16_t* Qw = P + (size_t)(qrow0 + wid * 32 + r32) * DIN + C_Q + h * 128 + mp * 64 + hi * 8;
        attn_map<VAR>(Qw, P + C_K + h * 128 + mp * 64, P + C_V + h * 128, ctx_row0, lat_row0, nct, NT, lds, o, l_reg);
        if (hi == 0) li_l[r32] = l_reg; asm volatile("s_waitcnt lgkmcnt(0)" ::: "memory");
        float rli[16];
#pragma unroll
        for (int r = 0; r < 16; ++r) rli[r] = __builtin_amdgcn_rcpf(li_l[crow(r, hi)]);
        if (mp == 1) __syncthreads();
        LAS bf16_t* ol = (LAS bf16_t*)(lds + (mp == 0 ? LDS_OA : LDS_OB)) + (wid * 32 + 4 * hi) * 128 + r32;
#pragma unroll
        for (int r = 0; r < 16; ++r)
#pragma unroll
            for (int d0 = 0; d0 < 4; ++d0) ol[((r & 3) + 8 * (r >> 2)) * 128 + d0 * 32] = (bf16_t)(cvtpk(o[d0][r] * rli[r], 0.f) & 0xffffu);
        if (mp == 1) {
            asm volatile("s_waitcnt lgkmcnt(0)" ::: "memory");
            int c4 = r32 * 4; asm volatile("" : "+v"(c4));
            const f32x4 g4 = *(const f32x4*)(p.subln_g + l * 128 + c4) * oml;
            const LAS bf16_t* A = (const LAS bf16_t*)(lds + LDS_OA) + (wid * 32 + hi) * 128 + c4;
            const LAS bf16_t* B = (const LAS bf16_t*)(lds + LDS_OB) + (wid * 32 + hi) * 128 + c4;
            const bf16_t* agp = P + (size_t)(qrow0 + wid * 32 + hi) * DIN + C_AG + h * 128 + c4;
            bf16_t* yp = Y + (size_t)(qrow0 + wid * 32 + hi) * DM + 512 + h * 128 + c4;
#pragma unroll 2
            for (int st = 0; st < 16; ++st) {
                const u32x2 av = *(const LAS u32x2*)(A + st * 256), bv = *(const LAS u32x2*)(B + st * 256);
                const u32x2 ag = *(const u32x2*)(agp + (size_t)(st * 2) * DIN);
                const float f0 = bflo(av.x) - lam * bflo(bv.x), f1 = bfhi(av.x) - lam * bfhi(bv.x), f2 = bflo(av.y) - lam * bflo(bv.y), f3 = bfhi(av.y) - lam * bfhi(bv.y);
                float ss = (f0 * f0 + f1 * f1) + (f2 * f2 + f3 * f3);
#pragma unroll
                for (int off = 1; off < 32; off <<= 1) ss += __shfl_xor(ss, off);
                const float rstd = __builtin_amdgcn_rsqf(ss * (1.f / 128.f) + RMS_EPS);
                const float y0 = f0 * rstd * g4[0] * silu_f(bflo(ag.x)), y1 = f1 * rstd * g4[1] * silu_f(bfhi(ag.x));
                const float y2 = f2 * rstd * g4[2] * silu_f(bflo(ag.y)), y3 = f3 * rstd * g4[3] * silu_f(bfhi(ag.y));
                u32x2 w; w.x = cvtpk(y0, y1); w.y = cvtpk(y2, y3);
                *(u32x2*)(yp + (size_t)(st * 2) * DM) = w;
            }
        }
    }
}
#undef KSW
#undef SBAR
}

__device__ __forceinline__ void seq_bounds(int R0, int& s0, int& s1) { if (R0 < NLAT) { s0 = R0 & ~(SEQ - 1); s1 = s0 + SEQ; } else { s0 = NLAT + ((R0 - NLAT) & ~(CTXL - 1)); s1 = s0 + CTXL; } }

__device__ __forceinline__ void unpack8(const u32x4 w, float (&f)[8]) { f[0] = bflo(w.x); f[1] = bfhi(w.x); f[2] = bflo(w.y); f[3] = bfhi(w.y); f[4] = bflo(w.z); f[5] = bfhi(w.z); f[6] = bflo(w.w); f[7] = bfhi(w.w); }

__device__ __forceinline__ void conv_item(const Params& p, int l, int rt) {
    const int tid = otid(), ch0 = (tid & 63) * 8, R0 = rt * 64, r0 = R0 + (tid >> 6) * 8; int s0, s1; seq_bounds(R0, s0, s1);
    const bf16_t* P = (const bf16_t*)(p.ws + OFF_P); bf16_t* Y = (bf16_t*)(p.ws + OFF_HY);
    const float* cw = p.conv_w + l * 3 * 512 + ch0;
    float w0[8], w1[8], w2[8];
#pragma unroll
    for (int j = 0; j < 8; ++j) { w0[j] = cw[j]; w1[j] = cw[512 + j]; w2[j] = cw[1024 + j]; }
#define LD16(row, sect) (*(const u32x4*)(P + (size_t)(row) * DIN + (sect) * 512 + ch0))
#pragma unroll 1
    for (int hb = 0; hb < 2; ++hb) {
        const int rb = r0 + hb * 4;
        u32x4 uu[6], cc[6], bb[4], gg[4];
#pragma unroll
        for (int i = 0; i < 6; ++i) { int rr = rb - 1 + i; rr = rr < s0 ? s0 : (rr >= s1 ? s1 - 1 : rr); uu[i] = LD16(rr, 0); cc[i] = LD16(rr, 2); }
#pragma unroll
        for (int i = 0; i < 4; ++i) { bb[i] = LD16(rb + i, 1); gg[i] = LD16(rb + i, 3); }
        float v[6][8];
#pragma unroll
        for (int i = 0; i < 6; ++i) { const int rr = rb - 1 + i; const float mk = (rr >= s0 && rr < s1) ? 1.f : 0.f; float a[8], c[8]; unpack8(uu[i], a); unpack8(cc[i], c);
#pragma unroll
            for (int j = 0; j < 8; ++j) v[i][j] = a[j] * c[j] * mk; }
#pragma unroll
        for (int i = 0; i < 4; ++i) { float a[8], g8[8], y[8]; unpack8(bb[i], a); unpack8(gg[i], g8);
#pragma unroll
            for (int j = 0; j < 8; ++j) y[j] = silu_f(g8[j]) * a[j] * (w0[j] * v[i][j] + w1[j] * v[i + 1][j] + w2[j] * v[i + 2][j]);
            u32x4 w; w.x = pk2(y[0], y[1]); w.y = pk2(y[2], y[3]); w.z = pk2(y[4], y[5]); w.w = pk2(y[6], y[7]);
            *(u32x4*)(Y + (size_t)(rb + i) * DM + ch0) = w; }
    }
#undef LD16
}

__device__ __forceinline__ void pool_block(const Params& p, int l, int g, int rt0, int rt_step, int nrt, LAS unsigned char* lds) {
    const int tid = otid();
    const bf16_t* P = (const bf16_t*)(p.ws + OFF_P); bf16_t* Y = (bf16_t*)(p.ws + OFF_HY);
    LAS bf16_t* ut = (LAS bf16_t*)lds;
    LAS bf16_t* dt = ut + 80 * 136;
    LAS bf16_t* wt = dt + 64 * 136;
    LAS float* st = (LAS float*)(wt + 128 * 136);
    if (rt0 >= nrt) return;
    { const bf16_t* PWT = (const bf16_t*)(p.ws + OFF_PWT) + (size_t)(l * 4 + g) * 128 * 128;
      for (int c = tid; c < 2048; c += NTHREADS) { const int row = c >> 4, ch = c & 15; *(LAS u32x4*)(wt + row * 136 + ch * 8) = *(const u32x4*)(PWT + row * 128 + ch * 8); } }
    const int erow = tid >> 4, ech = (tid & 15) * 8;
    float sc8[8];
#pragma unroll
    for (int j = 0; j < 8; ++j) sc8[j] = p.pool_scale[l * 512 + g * 128 + ech + j];
#define ULOAD(rt_, A, B, C) do { const int R0_ = (rt_) * 64; int s0_, s1_; seq_bounds(R0_, s0_, s1_); \
    { const int c = tid, row = c >> 4, ch = c & 15, gr = R0_ - 8 + row; A = (u32x4){0u, 0u, 0u, 0u}; if (gr >= s0_ && gr < s1_) A = *(const u32x4*)(P + (size_t)gr * DIN + C_PU + g * 128 + ch * 8); } \
    { const int c = tid + 512, row = c >> 4, ch = c & 15, gr = R0_ - 8 + row; B = (u32x4){0u, 0u, 0u, 0u}; if (gr >= s0_ && gr < s1_) B = *(const u32x4*)(P + (size_t)gr * DIN + C_PU + g * 128 + ch * 8); } \
    { const int c = tid + 1024, row = c >> 4, ch = c & 15, gr = R0_ - 8 + row; C = (u32x4){0u, 0u, 0u, 0u}; if (tid < 256 && gr >= s0_ && gr < s1_) C = *(const u32x4*)(P + (size_t)gr * DIN + C_PU + g * 128 + ch * 8); } } while (0)
    u32x4 ua, ub, uc; ULOAD(rt0, ua, ub, uc);
    for (int rt = rt0; rt < nrt; rt += rt_step) {
        const int R0 = rt * 64; int s0, s1; seq_bounds(R0, s0, s1);
        *(LAS u32x4*)(ut + (tid >> 4) * 136 + (tid & 15) * 8) = ua; *(LAS u32x4*)(ut + ((tid + 512) >> 4) * 136 + (tid & 15) * 8) = ub;
        if (tid < 256) *(LAS u32x4*)(ut + ((tid + 1024) >> 4) * 136 + (tid & 15) * 8) = uc;
        const u32x4 pg0 = *(const u32x4*)(P + (size_t)(R0 + erow) * DIN + C_PG + g * 128 + ech), pg1 = *(const u32x4*)(P + (size_t)(R0 + erow + 32) * DIN + C_PG + g * 128 + ech);
        if (rt + rt_step < nrt) ULOAD(rt + rt_step, ua, ub, uc);
        __syncthreads();
        { const int cp = tid & 63, rg = tid >> 6, hw = 1 << g, t0 = R0 + rg * 8;
#define LDU(lrow) (*(const LAS unsigned*)(ut + (lrow) * 136 + 2 * cp))
          float a0 = 0.f, a1 = 0.f;
          for (int j = -hw; j < hw; ++j) { const unsigned u = LDU(rg * 8 + 8 + j); a0 += bflo(u); a1 += bfhi(u); }
#pragma unroll
          for (int i = 0; i < 8; ++i) { const int t = t0 + i, lr = rg * 8 + 8 + i; const int lo_t = (t - hw < s0) ? s0 : t - hw, hi_t = (t + hw > s1) ? s1 : t + hw;
              const float inv = 1.f / (float)(hi_t - lo_t); const unsigned u = LDU(lr);
              *(LAS unsigned*)(dt + (rg * 8 + i) * 136 + 2 * cp) = pk2(a0 * inv - bflo(u), a1 * inv - bfhi(u));
              const unsigned un = LDU(lr + hw), uo = LDU(lr - hw);
              a0 += bflo(un) - bflo(uo); a1 += bfhi(un) - bfhi(uo); }
#undef LDU
        }
        __syncthreads();
        { const int wid = tid >> 6, lane = tid & 63, mt = wid & 3, nh = wid >> 2, fr = lane & 15, fq = lane >> 4;
          f32x4 acc[4];
#pragma unroll
          for (int n = 0; n < 4; ++n) acc[n] = (f32x4){0.f, 0.f, 0.f, 0.f};
#pragma unroll
          for (int ks = 0; ks < 4; ++ks) { const bf16x8 a = *(const LAS bf16x8*)(dt + (mt * 16 + fr) * 136 + ks * 32 + fq * 8);
#pragma unroll
              for (int n = 0; n < 4; ++n) { const bf16x8 b = *(const LAS bf16x8*)(wt + (nh * 64 + n * 16 + fr) * 136 + ks * 32 + fq * 8);
                  acc[n] = __builtin_amdgcn_mfma_f32_16x16x32_bf16(a, b, acc[n], 0, 0, 0); } }
#pragma unroll
          for (int n = 0; n < 4; ++n)
#pragma unroll
              for (int j = 0; j < 4; ++j) st[(mt * 16 + 4 * fq + j) * 132 + nh * 64 + n * 16 + fr] = acc[n][j]; }
        __syncthreads();
#pragma unroll
        for (int h2 = 0; h2 < 2; ++h2) { const int row = erow + 32 * h2; float gv[8]; unpack8(h2 ? pg1 : pg0, gv);
            const f32x4 x0 = *(const LAS f32x4*)(st + row * 132 + ech), x1 = *(const LAS f32x4*)(st + row * 132 + ech + 4);
            float y[8];
#pragma unroll
            for (int j = 0; j < 8; ++j) y[j] = silu_f(gv[j]) * sc8[j] * (j < 4 ? x0[j] : x1[j - 4]);
            u32x4 w; w.x = pk2(y[0], y[1]); w.y = pk2(y[2], y[3]); w.z = pk2(y[4], y[5]); w.w = pk2(y[6], y[7]);
            *(u32x4*)(Y + (size_t)(R0 + row) * DM + 1536 + g * 128 + ech) = w; }
    }
#undef ULOAD
    __syncthreads();
}

__device__ __forceinline__ void phase_mix(const Params& p, int l, LAS unsigned char* lds) {
    const int G = gridDim.x, blk = blockIdx.x, lane = otid() & 63;
    const float lam_init = (l == 0) ? 0.2f : 0.35550906759096935f;
    float lam;
    { const float a = p.lq1[l * 64 + lane] * p.lk1[l * 64 + lane], b = p.lq2[l * 64 + lane] * p.lk2[l * 64 + lane];
      lam = __expf(wave_sum(a)) - __expf(wave_sum(b)) + lam_init; }
    const int nrt = (l == 0) ? MROWS / 64 : NLAT / 64;
    const int n_conv = nrt, n_pool = nrt * 4, n_cattn = (l == 0) ? 32 : 0;
#ifndef NO_CONV
    for (int it = blk; it < n_conv; it += G) conv_item(p, l, it);
#endif
#ifndef NO_POOL
    if ((G & 3) == 0) pool_block(p, l, blk & 3, blk >> 2, G >> 2, nrt, lds); else for (int g4 = 0; g4 < 4; ++g4) pool_block(p, l, g4, blk, G, nrt, lds);
#endif
#ifdef PROBE_CP2
    for (int it = blk; it < n_conv; it += G) conv_item(p, l, it);
    if ((G & 3) == 0) pool_block(p, l, blk & 3, blk >> 2, G >> 2, nrt, lds); else for (int g4 = 0; g4 < 4; ++g4) pool_block(p, l, g4, blk, G, nrt, lds);
#endif
#ifndef NO_LATTN
    for (int u = blk; u < 512 + n_cattn; u += G) {
        int h, qrow0, crow0, lrow0, NT;
        if (u < 512) {
            int bh, qb;
            if (G == 256) { const int i = u >> 8, xcd = blk & 7, j = blk >> 3; bh = xcd * 4 + i * 2 + (j >> 4); qb = j & 15; }
            else { bh = u >> 4; qb = u & 15; }
            const int b = bh >> 3; h = bh & 7; qrow0 = b * SEQ + qb * 256; crow0 = NLAT + b * CTXL; lrow0 = b * SEQ; NT = 68;
        } else { const int q = u - 512, b = q >> 3; h = q & 7; qrow0 = NLAT + b * CTXL; crow0 = qrow0; lrow0 = qrow0; NT = 4; }
        att::attn_unit<0>(p, l, h, qrow0, crow0, lrow0, 4, NT, lam, 1.f - lam_init, (LAS char*)lds, (bf16_t*)(p.ws + OFF_HY));
    }
#endif
#ifdef PROBE_ATT
    if (l == 0) for (int u = blk; u < 512; u += G) {
        int bh, qb; if (G == 256) { const int i = u >> 8, xcd = blk & 7, j = blk >> 3; bh = xcd * 4 + i * 2 + (j >> 4); qb = j & 15; } else { bh = u >> 4; qb = u & 15; }
        const int b = bh >> 3, h = bh & 7;
        att::attn_unit<PROBE_ATT - 1>(p, l, h, b * SEQ + qb * 256, NLAT + b * CTXL, b * SEQ, 4, 68, lam, 1.f - lam_init, (LAS char*)lds, (bf16_t*)(p.ws + WS_END));
    }
#endif
    __syncthreads();
}

__device__ __forceinline__ void phase_ln(const Params& p, int l, bool final) {
    const int G = gridDim.x, tid = otid(), wid = tid >> 6, lane = tid & 63;
    const int nrows = final ? NLAT : MROWS;
    const float* MODF = (const float*)(p.ws + OFF_MODF); bf16_t* H = (bf16_t*)(p.ws + OFF_HY);
    const float* lg = p.ln_g + l * DM; const float* lb = p.ln_b + l * DM;
    for (int row = blockIdx.x * 8 + wid; row < nrows; row += G * 8) {
        const bool lat = row < NLAT;
        float* src = lat ? p.out + (size_t)row * DM : (float*)(p.ws + OFF_ZC) + (size_t)(row - NLAT) * DM;
        f32x4 v[8]; float s = 0.f;
#pragma unroll
        for (int i = 0; i < 8; ++i) { v[i] = *(const f32x4*)(src + (i * 64 + lane) * 4); s += (v[i][0] + v[i][1]) + (v[i][2] + v[i][3]); }
        const float mean = wave_sum(s) * (1.f / DM); float q = 0.f;
#pragma unroll
        for (int i = 0; i < 8; ++i) { const f32x4 d = v[i] - mean; q += (d[0] * d[0] + d[1] * d[1]) + (d[2] * d[2] + d[3] * d[3]); }
        const float rstd = __builtin_amdgcn_rsqf(wave_sum(q) * (1.f / DM) + LN_EPS);
        const int b = lat ? (row >> 12) : 4;
#pragma unroll
        for (int i = 0; i < 8; ++i) { const int col = (i * 64 + lane) * 4;
            const f32x4 xn = (v[i] - mean) * rstd * *(const f32x4*)(lg + col) + *(const f32x4*)(lb + col);
            if (lat) *(f32x4*)(src + col) = xn;
            if (!final) { const f32x4 sh = *(const f32x4*)(MODF + (size_t)(5 + b) * 6144 + col), sc = *(const f32x4*)(MODF + (size_t)(5 + b) * 6144 + 2048 + col);
                const f32x4 h = xn * (sc + 1.f) + sh; u32x2 w; w.x = pk2(h[0], h[1]); w.y = pk2(h[2], h[3]); *(u32x2*)(H + (size_t)row * DM + col) = w; } }
    }
}

#define XB_TMO      128
#define XB_XCNT(j)  (256  + 64 * (j))
#define XB_XSUB(j)  (1280 + 64 * (j))
#define XB_XGEN(j)  (2304 + 64 * (j))
#define XB_TOP      3328
#define XB_TOPGEN   3392
#define XCD_BAR_WORDS 3456
#define XB_SPIN_CAP (1u << 18)

__device__ __forceinline__ unsigned xb_ld(unsigned* p)              { return __hip_atomic_load(p, __ATOMIC_RELAXED, __HIP_MEMORY_SCOPE_AGENT); }
__device__ __forceinline__ unsigned xb_add(unsigned* p, unsigned v) { return __hip_atomic_fetch_add(p, v, __ATOMIC_RELAXED, __HIP_MEMORY_SCOPE_AGENT); }
__device__ __forceinline__ unsigned xb_xcc_id() { return (unsigned)__builtin_amdgcn_s_getreg((3 << 11) | 20) & 0xFu; }
#define XB_SPIN(cond, bar) do { unsigned _sp = 0; while (cond) { __builtin_amdgcn_s_sleep(1); \
    if ((++_sp & 255u) == 0u) { if (xb_ld(&(bar)[XB_TMO])) break; if (_sp > XB_SPIN_CAP) { atomicAdd(&(bar)[XB_TMO], 1u); break; } } } } while (0)

struct XcdBarrier {
    unsigned* bar; unsigned x;
    volatile LAS unsigned* st;
};

__device__ __forceinline__ XcdBarrier xcd_barrier_post(unsigned* bar, volatile LAS unsigned* st) {
    XcdBarrier b; b.bar = bar; b.x = xb_xcc_id(); b.st = st;
    if (threadIdx.x == 0) (void)xb_add(&bar[XB_XCNT(b.x)], 1u);
    return b;
}
__device__ __forceinline__ void xcd_barrier_complete(unsigned* bar, unsigned x, unsigned& nloc, unsigned& nx) {
    const unsigned G = gridDim.x * gridDim.y * gridDim.z;
    unsigned sum, cnt, mine, sp = 0u;
    for (;;) {
        sum = 0u; cnt = 0u; mine = 0u;
#pragma unroll
        for (unsigned j = 0; j < 16; ++j) { const unsigned c = xb_ld(&bar[XB_XCNT(j)]); sum += c; cnt += (c > 0u) ? 1u : 0u; mine = (j == x) ? c : mine; }
        if (sum == G) break;
        __builtin_amdgcn_s_sleep(1);
        if ((++sp & 255u) == 0u) { if (xb_ld(&bar[XB_TMO])) break; if (sp > XB_SPIN_CAP) { atomicAdd(&bar[XB_TMO], 1u); break; } }
    }
    nloc = mine > 0u ? mine : 1u; nx = cnt > 0u ? cnt : 1u;
}

__device__ __forceinline__ void xcd_barrier(const XcdBarrier& b) {
    asm volatile("s_waitcnt vmcnt(0)" ::: "memory");
    __syncthreads();
    if (threadIdx.x == 0) {
        unsigned* bar = b.bar;
        __builtin_amdgcn_s_waitcnt(0);
        unsigned nloc = b.st[0], nx = b.st[1];
        if (nloc == 0u) { xcd_barrier_complete(bar, b.x, nloc, nx); b.st[0] = nloc; b.st[1] = nx; }
        const unsigned old = xb_add(&bar[XB_XSUB(b.x)], 1u);
        const unsigned gen = old / nloc;
        if (old + 1u == (gen + 1u) * nloc) {
            __builtin_amdgcn_fence(__ATOMIC_RELEASE, "agent");
            asm volatile("s_waitcnt vmcnt(0)" ::: "memory");
            const unsigned og = xb_add(&bar[XB_TOP], 1u);
            const unsigned tg = og / nx;
            if (og + 1u == (tg + 1u) * nx) xb_add(&bar[XB_TOPGEN], 1u);
            else XB_SPIN(xb_ld(&bar[XB_TOPGEN]) == tg, bar);
            __builtin_amdgcn_fence(__ATOMIC_ACQUIRE, "agent");
            xb_add(&bar[XB_XGEN(b.x)], 1u);
            asm volatile("s_waitcnt vmcnt(0)" ::: "memory");
        } else {
            XB_SPIN(xb_ld(&bar[XB_XGEN(b.x)]) == gen, bar);
            __builtin_amdgcn_fence(__ATOMIC_ACQUIRE, "agent");
            asm volatile("s_waitcnt vmcnt(0)" ::: "memory");
        }
    }
    __syncthreads();
}

__global__ void __launch_bounds__(NTHREADS, 2) hybrid_fwd(Params p) {
    extern __shared__ __attribute__((aligned(16))) unsigned char lds_g[];
    LAS unsigned char* lds = (LAS unsigned char*)lds_g;
    cg::grid_group grid = cg::this_grid();
    { volatile LAS unsigned* st0 = (volatile LAS unsigned*)(lds + 147456 + 64); if (threadIdx.x < 2) st0[threadIdx.x] = 0u; }
    __syncthreads();
    XcdBarrier xbar = xcd_barrier_post((unsigned*)p.ws, (volatile LAS unsigned*)(lds + 147456 + 64));
#define GSYNC() xcd_barrier(xbar)
    const int G = gridDim.x;

#ifndef PH_MASK
#define PH_MASK 0xFF
#endif
    if (gridDim.y == 0x7fffu) grid.sync();
    if constexpr (PH_MASK & 1) phase0(p, lds);
    GSYNC();
    if constexpr (PH_MASK & 2) phase_mod0(p);
    GSYNC();
#pragma unroll 1
    for (int l = 0; l < 2; ++l) {
        if constexpr (PH_MASK & 4) {
            pg8::Gemm g{(const bf16_t*)(p.ws + OFF_HY), (const bf16_t*)(p.ws + OFF_WTIN) + (size_t)l * DIN * DM, (l == 0) ? MROWS : NLAT, DIN, DM};
            OrderX S; S.base.init((l == 0) ? MROWS : NLAT, DIN, G, (int)blockIdx.x); S.nextra = (l == 0) ? 0 : 32; S.epm0 = 64; S.epn0 = 12; S.epnn = 8;
            EpiIn E{(bf16_t*)(p.ws + OFF_P), (const float*)(p.ws + OFF_ROPE)};
            pg8::gemm_phase<EpiIn, OrderX, true, true>(lds, g, S, E);
        }
        GSYNC();
        if constexpr (PH_MASK & 8) phase_mix(p, l, lds);
#ifdef PROBE_MIX2
        GSYNC(); phase_mix(p, l, lds);
#endif
        GSYNC();
        if constexpr (PH_MASK & 16) {
            pg8::Gemm g{(const bf16_t*)(p.ws + OFF_HY), (const bf16_t*)(p.ws + OFF_WTOUT) + (size_t)l * DM * DM, (l == 0) ? MROWS : NLAT, DM, DM};
            OrderX S; S.base.init((l == 0) ? MROWS : NLAT, DM, G, (int)blockIdx.x); S.nextra = 0; S.epm0 = 0; S.epn0 = 0; S.epnn = 1;
            EpiOut E{(l == 0) ? p.x : p.out, p.ctx, p.out, (float*)(p.ws + OFF_ZC), (const float*)(p.ws + OFF_MODF) + (size_t)l * 5 * 6144 + 4096};
            pg8::gemm_phase<EpiOut, OrderX, true, true>(lds, g, S, E);
        }
        GSYNC();
        if constexpr (PH_MASK & 32) phase_ln(p, l, l == 1);
        if (l == 0) GSYNC();
    }
}

extern "C" void kernel_launch(void* const* d_in, const int* in_sizes, int n_in, void* d_out, int out_size, void* d_ws, size_t ws_size, hipStream_t stream) {
    static int grid_blocks = 0;
    if (grid_blocks == 0) {
        if (n_in != 18 || in_sizes[0] != NLAT * DM || out_size != NLAT * DM || ws_size < WS_END) {
            fprintf(stderr, "kernel_launch: shape/workspace mismatch: n_in %d in0 %d out %d ws %zu (need %zu)\n", n_in, n_in > 0 ? in_sizes[0] : -1, out_size, ws_size, (size_t)WS_END); grid_blocks = -1; return; }
        int dev = 0, cus = 0, per_cu = 0;
        hipGetDevice(&dev); hipDeviceGetAttribute(&cus, hipDeviceAttributeMultiprocessorCount, dev);
        if (hipFuncSetAttribute((const void*)hybrid_fwd, hipFuncAttributeMaxDynamicSharedMemorySize, LDS_BYTES) != hipSuccess) { fprintf(stderr, "kernel_launch: hipFuncSetAttribute failed\n"); grid_blocks = -1; return; }
        if (hipOccupancyMaxActiveBlocksPerMultiprocessor(&per_cu, (const void*)hybrid_fwd, NTHREADS, LDS_BYTES) != hipSuccess || per_cu < 1) { fprintf(stderr, "kernel_launch: occupancy query gave %d\n", per_cu); per_cu = 1; }
        (void)hipGetLastError();
        grid_blocks = cus * 1;
        if (grid_blocks > 256) grid_blocks = 256;
    }
    if (grid_blocks < 0) return;
    Params p{};
    p.x = (const float*)d_in[0]; p.c = (const float*)d_in[1]; p.ctx = (const float*)d_in[2]; p.c_ctx = (const float*)d_in[3]; p.w_mod = (const float*)d_in[4]; p.b_mod = (const float*)d_in[5];
    p.w_in = (const float*)d_in[6]; p.conv_w = (const float*)d_in[7]; p.lq1 = (const float*)d_in[8]; p.lk1 = (const float*)d_in[9]; p.lq2 = (const float*)d_in[10]; p.lk2 = (const float*)d_in[11];
    p.subln_g = (const float*)d_in[12]; p.pool_w = (const float*)d_in[13]; p.pool_scale = (const float*)d_in[14]; p.w_out = (const float*)d_in[15]; p.ln_g = (const float*)d_in[16]; p.ln_b = (const float*)d_in[17];
    p.out = (float*)d_out; p.ws = (unsigned char*)d_ws;
    if (hipMemsetAsync(d_ws, 0, 16384, stream) != hipSuccess) { fprintf(stderr, "kernel_launch: hipMemsetAsync failed\n"); return; }
    void* args[] = {&p};
    const hipError_t e = hipLaunchCooperativeKernel((const void*)hybrid_fwd, dim3(grid_blocks), dim3(NTHREADS), args, LDS_BYTES, stream);
    if (e != hipSuccess) fprintf(stderr, "kernel_launch: cooperative launch failed: %s (grid %d)\n", hipGetErrorString(e), grid_blocks);
}
```

```cpp
#include <hip/hip_runtime.h>
#include <hip/hip_cooperative_groups.h>
#include <cstdio>
#include <cstdint>
namespace cg = cooperative_groups;
__device__ __forceinline__ int otid() { int t = threadIdx.x; asm volatile("" : "+v"(t)); return t; }
namespace pg8 {
#define PG8_LAS __attribute__((address_space(3)))
typedef unsigned short bf16_t;
typedef short bf16x8 __attribute__((ext_vector_type(8)));
typedef float f32x4 __attribute__((ext_vector_type(4)));
typedef unsigned u32x4 __attribute__((ext_vector_type(4)));
constexpr int BM = 256, BK = 64, HALF = 128, HTB = HALF * BK * 2  , STAGE_BYTES = 8 * HTB, NXCD = 8, WGM = 8;

__host__ __device__ __forceinline__ int lds_byte(int r, int c) { const int st = (r >> 4) * 2 + (c >> 5), rr = r & 15, cc = c & 31, ob = rr * 64 + cc * 2; return st * 1024 + (ob ^ (((ob >> 9) & 1) << 5)); }
__host__ __device__ __forceinline__ void stage_rc(int b, int& R, int& C) { const int st = b / 1024, sb = b % 1024, swz = sb ^ (((sb >> 9) & 1) << 5); R = (st >> 1) * 16 + swz / 64; C = (st & 1) * 32 + (swz % 64) / 2; }
__host__ __device__ __forceinline__ int perm32(int rho) { const int n = rho >> 4, i = rho & 15; return 8 * (i >> 2) + 4 * n + (i & 3); }

struct Unit { int pm, pn; };
struct Gemm { const bf16_t* A; const bf16_t* Bt; int M, N, K; };

struct StaticOrder {
    int nM, nN, nwg, G, c;
    __host__ __device__ void init(int M, int N, int G_, int c_) { nM = M / BM; nN = N / BM; nwg = nM * nN; G = G_; c = c_; }
    __host__ __device__ bool next(int i, Unit& u) const {
        const long L = (long)i * G + c; if (L >= nwg) return false;
        int wgid = (int)L; { const int q = nwg / NXCD, r = nwg % NXCD, xcd = wgid % NXCD, off = wgid / NXCD; wgid = (xcd < r ? xcd * (q + 1) : r * (q + 1) + (xcd - r) * q) + off; }
        const int nig = WGM * nN, gid = wgid / nig, fm = gid * WGM, gsz = (nM - fm) < WGM ? (nM - fm) : WGM;
        u.pm = fm + ((wgid % nig) % gsz); u.pn = (wgid % nig) / gsz; return true;
    }
    __device__ __forceinline__ void a_ready(const Unit&) const {}
    __device__ __forceinline__ void done(const Unit&) const {}
};

__device__ __forceinline__ unsigned cvt_pk_bf16(float lo, float hi) { unsigned r; asm volatile("v_cvt_pk_bf16_f32 %0, %1, %2" : "=v"(r) : "v"(lo), "v"(hi)); return r; }

template <class Epi, class Sched, bool ALIGN_EPI = false, bool SP2 = false>
__device__ __forceinline__ void gemm_phase(PG8_LAS unsigned char* lds, const Gemm g, const Sched& S, const Epi& E) {
    const int tid = otid(), wid = __builtin_amdgcn_readfirstlane(tid >> 6), lane = tid & 63, wr = wid >> 2, wc = wid & 3, fr = lane & 15, fq = lane >> 4;
    const int K = g.K, nt = K / BK;
    unsigned voffA[2], voffB[2];
#pragma unroll
    for (int i = 0; i < 2; ++i) { int R, C; stage_rc(tid * 16 + i * 8192, R, C); const int Rb = Epi::PERM ? ((R & ~31) + perm32(R & 31)) : R;
        voffA[i] = (unsigned)(R * K + C) * 2u; voffB[i] = (unsigned)(Rb * K + C) * 2u; }
    const size_t kstep = (size_t)(BK * 2);
    const size_t hstep = (size_t)HALF * K * 2;
    const size_t tstep = 2 * hstep;
    const unsigned ldsw = (unsigned)wid * 1024u;
    const int aoff = lds_byte(wr * 64 + fr, fq * 8), boff = lds_byte(wc * 32 + fr, fq * 8);
#define PG8_SA(b, h) (((b) * 2 + (h)) * HTB)
#define PG8_SB(b, h) ((4 + (b) * 2 + (h)) * HTB)
#define PG8_STAGE(bufoff, gbase, voff) do { _Pragma("unroll") for (int _i = 0; _i < 2; ++_i) \
        __builtin_amdgcn_global_load_lds((const unsigned*)((const char*)(gbase) + (voff)[_i]), (PG8_LAS unsigned*)(lds + (bufoff) + ldsw + _i * 8192), 16, 0, 0); } while (0)
#define PG8_LDA(dst, b, h) do { _Pragma("unroll") for (int m = 0; m < 4; ++m) _Pragma("unroll") for (int k = 0; k < 2; ++k) dst[m][k] = *(const PG8_LAS bf16x8*)(lds + PG8_SA(b, h) + aoff + m * 2048 + k * 1024); } while (0)
#define PG8_LDB(dst, b, h) do { _Pragma("unroll") for (int n = 0; n < 2; ++n) _Pragma("unroll") for (int k = 0; k < 2; ++k) dst[n][k] = *(const PG8_LAS bf16x8*)(lds + PG8_SB(b, h) + boff + n * 2048 + k * 1024); } while (0)
#define PG8_MMA(ai, bj, At, Bt) do { __builtin_amdgcn_s_setprio(1); _Pragma("unroll") for (int m = 0; m < 4; ++m) _Pragma("unroll") for (int n = 0; n < 2; ++n) _Pragma("unroll") for (int k = 0; k < 2; ++k) \
        acc[ai][bj][m][n] = __builtin_amdgcn_mfma_f32_16x16x32_bf16(Bt[n][k], At[m][k], acc[ai][bj][m][n], 0, 0, 0); __builtin_amdgcn_s_setprio(0); } while (0)
#define PG8_WAIT_V(n) asm volatile("s_waitcnt vmcnt(" #n ")" ::: "memory")
#define PG8_WAIT_L(n) asm volatile("s_waitcnt lgkmcnt(" #n ")" ::: "memory")
#define PG8_BAR __builtin_amdgcn_s_barrier()
#define PG8_SCHED __builtin_amdgcn_sched_barrier(0)
    Unit cur, nxt; int ui = 0;
    if (!S.next(0, cur)) return;
    f32x4 acc[2][2][4][2];
#pragma unroll
    for (int a = 0; a < 2; ++a)
#pragma unroll
        for (int b = 0; b < 2; ++b)
#pragma unroll
            for (int m = 0; m < 4; ++m)
#pragma unroll
                for (int n = 0; n < 2; ++n) acc[a][b][m][n] = (f32x4){0.f, 0.f, 0.f, 0.f};
    bf16x8 At[4][2], B0[2][2], B1[2][2];
    const char* cA = (const char*)g.A + (size_t)cur.pm * tstep; const char* cB = (const char*)g.Bt + (size_t)cur.pn * tstep;
    S.a_ready(cur);
    if constexpr (SP2) {
        PG8_STAGE(PG8_SB(0, 0), cB, voffB); PG8_STAGE(PG8_SB(0, 1), cB + hstep, voffB); PG8_STAGE(PG8_SA(0, 0), cA, voffA); PG8_STAGE(PG8_SA(0, 1), cA + hstep, voffA);
        if (wr == 1) PG8_BAR;
        PG8_WAIT_V(2); PG8_BAR;
        PG8_STAGE(PG8_SB(1, 0), cB + kstep, voffB); PG8_STAGE(PG8_SA(1, 0), cA + kstep, voffA); PG8_STAGE(PG8_SB(1, 1), cB + hstep + kstep, voffB);
        PG8_WAIT_V(6); PG8_BAR;
    } else {
        PG8_STAGE(PG8_SB(0, 0), cB, voffB); PG8_STAGE(PG8_SA(0, 0), cA, voffA); PG8_STAGE(PG8_SB(0, 1), cB + hstep, voffB); PG8_STAGE(PG8_SA(0, 1), cA + hstep, voffA);
        if (wr == 1) PG8_BAR;
        PG8_WAIT_V(4); PG8_BAR;
        PG8_STAGE(PG8_SB(1, 0), cB + kstep, voffB); PG8_STAGE(PG8_SA(1, 0), cA + kstep, voffA); PG8_STAGE(PG8_SB(1, 1), cB + hstep + kstep, voffB);
        PG8_WAIT_V(6); PG8_BAR;
    }
    for (;;) {
        const bool has_next = S.next(ui + 1, nxt);
        const char* nA = has_next ? (const char*)g.A + (size_t)nxt.pm * tstep : cA; const char* nB = has_next ? (const char*)g.Bt + (size_t)nxt.pn * tstep : cB;
        for (int t = 0; t < nt; t += 2) {
            const bool last = (t == nt - 2);
            const char* a1 = cA + (size_t)(t + 1) * kstep;
            const char* a2 = last ? nA : cA + (size_t)(t + 2) * kstep; const char* b2 = last ? nB : cB + (size_t)(t + 2) * kstep;
            const char* a3 = a2 + kstep; const char* b3 = b2 + kstep;
            if (last && has_next) S.a_ready(nxt);
            if constexpr (SP2) {
            PG8_LDB(B0, 0, 0); PG8_LDB(B1, 0, 1); PG8_SCHED; PG8_LDA(At, 0, 0); PG8_STAGE(PG8_SA(1, 1), a1 + hstep, voffA);
            PG8_WAIT_V(8); PG8_WAIT_L(0); PG8_BAR; PG8_MMA(0, 0, At, B0); PG8_MMA(0, 1, At, B1); PG8_BAR; PG8_SCHED;
            PG8_LDA(At, 0, 1); PG8_STAGE(PG8_SB(0, 0), b2, voffB); PG8_STAGE(PG8_SB(0, 1), b2 + hstep, voffB); PG8_STAGE(PG8_SA(0, 0), a2, voffA);
            PG8_WAIT_V(8); PG8_WAIT_L(0); PG8_BAR; PG8_MMA(1, 0, At, B0); PG8_MMA(1, 1, At, B1); PG8_BAR; PG8_SCHED;
            PG8_LDB(B0, 1, 0); PG8_LDB(B1, 1, 1); PG8_SCHED; PG8_LDA(At, 1, 0); PG8_STAGE(PG8_SA(0, 1), a2 + hstep, voffA);
            PG8_WAIT_V(8); PG8_WAIT_L(0); PG8_BAR; PG8_MMA(0, 0, At, B0); PG8_MMA(0, 1, At, B1); PG8_BAR; PG8_SCHED;
            PG8_LDA(At, 1, 1); PG8_STAGE(PG8_SB(1, 0), b3, voffB); PG8_STAGE(PG8_SB(1, 1), b3 + hstep, voffB); PG8_STAGE(PG8_SA(1, 0), a3, voffA);
            PG8_WAIT_V(8); PG8_WAIT_L(0); PG8_BAR; PG8_MMA(1, 0, At, B0); PG8_MMA(1, 1, At, B1); PG8_BAR; PG8_SCHED;
            } else {
            PG8_LDB(B0, 0, 0); PG8_SCHED; PG8_LDA(At, 0, 0); PG8_STAGE(PG8_SA(1, 1), a1 + hstep, voffA);
            PG8_WAIT_L(8); PG8_BAR; PG8_WAIT_L(0); PG8_MMA(0, 0, At, B0); PG8_BAR; PG8_SCHED;
            PG8_LDB(B1, 0, 1); PG8_STAGE(PG8_SB(0, 0), b2, voffB);
            PG8_BAR; PG8_WAIT_L(0); PG8_MMA(0, 1, At, B1); PG8_BAR;
            PG8_LDA(At, 0, 1); PG8_STAGE(PG8_SA(0, 0), a2, voffA);
            PG8_BAR; PG8_WAIT_L(0); PG8_MMA(1, 0, At, B0); PG8_BAR; PG8_SCHED;
            PG8_STAGE(PG8_SB(0, 1), b2 + hstep, voffB);
            PG8_WAIT_V(6); PG8_BAR; PG8_MMA(1, 1, At, B1); PG8_BAR;
            PG8_LDB(B0, 1, 0); PG8_SCHED; PG8_LDA(At, 1, 0); PG8_STAGE(PG8_SA(0, 1), a2 + hstep, voffA);
            PG8_WAIT_L(8); PG8_BAR; PG8_WAIT_L(0); PG8_MMA(0, 0, At, B0); PG8_BAR; PG8_SCHED;
            PG8_LDB(B1, 1, 1); PG8_STAGE(PG8_SB(1, 0), b3, voffB);
            PG8_BAR; PG8_WAIT_L(0); PG8_MMA(0, 1, At, B1); PG8_BAR;
            PG8_LDA(At, 1, 1); PG8_STAGE(PG8_SA(1, 0), a3, voffA);
            PG8_BAR; PG8_WAIT_L(0); PG8_MMA(1, 0, At, B0); PG8_BAR; PG8_SCHED;
            PG8_STAGE(PG8_SB(1, 1), b3 + hstep, voffB);
            PG8_WAIT_V(6); PG8_BAR; PG8_MMA(1, 1, At, B1); PG8_BAR;
            }
        }
        if constexpr (ALIGN_EPI) { if (wr == 0) PG8_BAR; }
        if constexpr (!Epi::AFTER_DRAIN) { E(acc, cur, wr, wc, fr, fq); S.done(cur); }
        if (!has_next) break;
#pragma unroll
        for (int a = 0; a < 2; ++a)
#pragma unroll
            for (int b = 0; b < 2; ++b)
#pragma unroll
                for (int m = 0; m < 4; ++m)
#pragma unroll
                    for (int n = 0; n < 2; ++n) acc[a][b][m][n] = (f32x4){0.f, 0.f, 0.f, 0.f};
        cur = nxt; cA = nA; cB = nB; ++ui;
        if constexpr (ALIGN_EPI) { if (wr == 1) PG8_BAR; }
    }
    PG8_WAIT_V(0);
    if constexpr (!ALIGN_EPI) { if (wr == 0) PG8_BAR; }
    PG8_BAR;
    if constexpr (Epi::AFTER_DRAIN) { E.fused(acc, cur, wr, wc, fr, fq, lds, wid, lane); S.done(cur); }
#undef PG8_SA
#undef PG8_SB
#undef PG8_STAGE
#undef PG8_LDA
#undef PG8_LDB
#undef PG8_MMA
#undef PG8_WAIT_V
#undef PG8_WAIT_L
#undef PG8_BAR
#undef PG8_SCHED
}
}

using pg8::bf16_t; using pg8::bf16x8; using pg8::f32x4; using pg8::u32x4;
typedef float f32x16 __attribute__((ext_vector_type(16)));
typedef short s16x4 __attribute__((ext_vector_type(4)));
typedef unsigned u32x2 __attribute__((ext_vector_type(2)));
#define LAS __attribute__((address_space(3)))

constexpr int DM = 2048, NB = 4, SEQ = 4096, CTXL = 256, NLAT = NB * SEQ, NCTX = NB * CTXL, MROWS = NLAT + NCTX, DIN = 7168;
constexpr int C_Q = 2048, C_K = 3072, C_V = 4096, C_AG = 5120, C_PU = 6144, C_PG = 6656;
constexpr float LN_EPS = 1e-5f, RMS_EPS = 1e-5f;
constexpr float ALPHA = 1.4142135623730951f;
constexpr float QSCALE = 0.125f * 1.4426950408889634f;
constexpr int NTHREADS = 512;
constexpr int LDS_BYTES = 147456 + 1024;

constexpr size_t OFF_WTIN = 1u << 20;
constexpr size_t OFF_WTOUT = OFF_WTIN + (size_t)2 * DIN * DM * 2;
constexpr size_t OFF_PWT = OFF_WTOUT + (size_t)2 * DM * DM * 2;
constexpr size_t OFF_MODP = OFF_PWT + 262144;
constexpr size_t OFF_MODF = OFF_MODP + 983040;
constexpr size_t OFF_ROPE = OFF_MODF + 245760;
constexpr size_t OFF_HY = OFF_ROPE + 8192;
constexpr size_t OFF_P = OFF_HY + (size_t)MROWS * DM * 2;
constexpr size_t OFF_ZC = OFF_P + (size_t)MROWS * DIN * 2;
constexpr size_t OFF_O1 = OFF_ZC + (size_t)NCTX * DM * 4;
constexpr size_t WS_END = OFF_O1 + (size_t)256 * 256 * 128 * 4;

struct Params {
    const float *x, *c, *ctx, *c_ctx, *w_mod, *b_mod, *w_in, *conv_w, *lq1, *lk1, *lq2, *lk2, *subln_g, *pool_w, *pool_scale, *w_out, *ln_g, *ln_b;
    float* out; unsigned char* ws;
};

__device__ __forceinline__ float silu_f(float v) { return v / (1.f + __expf(-v)); }
__device__ __forceinline__ float bf2f(unsigned short b) { return __uint_as_float(((unsigned)b) << 16); }
__device__ __forceinline__ float bflo(unsigned w) { return __uint_as_float(w << 16); }
__device__ __forceinline__ float bfhi(unsigned w) { return __uint_as_float(w & 0xffff0000u); }
__device__ __forceinline__ unsigned pk2(float lo, float hi) { return pg8::cvt_pk_bf16(lo, hi); }
__device__ __forceinline__ float wave_sum(float v) {
#pragma unroll
    for (int o = 32; o >= 1; o >>= 1) v += __shfl_xor(v, o);
    return v;
}

__device__ __forceinline__ int rope_src(int j) { const int part = j >> 5, jj = j & 31; return part * 32 + (jj & 1) * 16 + (jj >> 1); }

__device__ __forceinline__ void transpose_tile(const float* __restrict__ src, int K, int N, bf16_t* __restrict__ dst, int k0, int n0, bool permq, LAS float* tile) {
    const int tid = otid();
    { const int r = tid >> 4, c4 = (tid & 15) * 4;
#pragma unroll
      for (int i = 0; i < 2; ++i) { const int k = r + 32 * i; const f32x4 v = *(const f32x4*)(src + (size_t)(k0 + k) * N + n0 + c4);
          tile[k * 65 + c4 + 0] = v[0]; tile[k * 65 + c4 + 1] = v[1]; tile[k * 65 + c4 + 2] = v[2]; tile[k * 65 + c4 + 3] = v[3]; } }
    __syncthreads();
    { const int n = tid >> 3, kc = (tid & 7) * 8; const int ns = permq ? rope_src(n) : n;
      float f[8];
#pragma unroll
      for (int j = 0; j < 8; ++j) f[j] = tile[(kc + j) * 65 + ns];
      u32x4 w; w.x = pk2(f[0], f[1]); w.y = pk2(f[2], f[3]); w.z = pk2(f[4], f[5]); w.w = pk2(f[6], f[7]);
      *(u32x4*)(dst + (size_t)(n0 + n) * K + k0 + kc) = w; }
    __syncthreads();
}

__device__ __forceinline__ void gemv_item(const Params& p, int item, LAS float* lds) {
    const int l = item / 192, rem = item % 192, kq = rem / 48, cgp = rem % 48, tid = threadIdx.x;
    LAS float* s = lds; LAS float* red = lds + 2560;
    float* MODP = (float*)(p.ws + OFF_MODP);
#pragma unroll
    for (int r = 0; r < 5; ++r) { const int k = kq * 512 + tid; const float v = (r < 4) ? p.c[r * DM + k] : p.c_ctx[k]; s[r * 512 + tid] = silu_f(v); }
    __syncthreads();
    const int kl = tid >> 5, c4 = tid & 31;
    const float* W = p.w_mod + (size_t)l * DM * 6144 + (size_t)(kq * 512) * 6144 + cgp * 128 + c4 * 4;
    f32x4 acc[5];
#pragma unroll
    for (int r = 0; r < 5; ++r) acc[r] = (f32x4){0.f, 0.f, 0.f, 0.f};
#pragma unroll 4
    for (int i = 0; i < 32; ++i) { const int k = kl + 16 * i; const f32x4 w = *(const f32x4*)(W + (size_t)k * 6144);
#pragma unroll
        for (int r = 0; r < 5; ++r) { const float sv = s[r * 512 + k]; acc[r] += w * sv; } }
#pragma unroll
    for (int r = 0; r < 5; ++r) { LAS float* q = red + (kl * 5 + r) * 128 + c4 * 4; q[0] = acc[r][0]; q[1] = acc[r][1]; q[2] = acc[r][2]; q[3] = acc[r][3]; }
    __syncthreads();
    for (int o = tid; o < 640; o += NTHREADS) { const int r = o >> 7, cc = o & 127; float sum = 0.f;
#pragma unroll
        for (int k2 = 0; k2 < 16; ++k2) sum += red[(k2 * 5 + r) * 128 + cc];
        MODP[(size_t)((l * 4 + kq) * 5 + r) * 6144 + cgp * 128 + cc] = sum; }
    __syncthreads();
}

constexpr int N_GEMV = 384, N_TIN = 3584, N_TOUT = 1024, N_TPOOL = 16, N_TRANS = N_TIN + N_TOUT + N_TPOOL;
constexpr int IT_TIN = N_GEMV, IT_ROPE = IT_TIN + 2 * N_TRANS, N_ITEMS0 = IT_ROPE + 1;
__device__ __forceinline__ void transpose_item(const Params& p, int l, int q, LAS float* fl) {
    if (q < N_TIN) { const int tk = q / 112, tn = q % 112;
        transpose_tile(p.w_in + (size_t)l * DM * DIN, DM, DIN, (bf16_t*)(p.ws + OFF_WTIN) + (size_t)l * DIN * DM, tk * 64, tn * 64, (tn * 64 >= C_Q && tn * 64 < C_V), fl); }
    else if (q < N_TIN + N_TOUT) { const int t = q - N_TIN, tk = t / 32, tn = t % 32;
        transpose_tile(p.w_out + (size_t)l * DM * DM, DM, DM, (bf16_t*)(p.ws + OFF_WTOUT) + (size_t)l * DM * DM, tk * 64, tn * 64, false, fl); }
    else { const int t = q - N_TIN - N_TOUT, mtx = l * 4 + (t >> 2), tk = (t >> 1) & 1, tn = t & 1;
        transpose_tile(p.pool_w + (size_t)mtx * 128 * 128, 128, 128, (bf16_t*)(p.ws + OFF_PWT) + (size_t)mtx * 128 * 128, tk * 64, tn * 64, false, fl); }
}

__device__ __forceinline__ void phase0(const Params& p, LAS unsigned char* lds) {
    LAS float* fl = (LAS float*)lds;
    for (int it = blockIdx.x; it < N_ITEMS0; it += gridDim.x) {
        if (it < IT_TIN) gemv_item(p, it, fl);
        else if (it < IT_ROPE) { const int q = it - IT_TIN; transpose_item(p, q & 1, q >> 1, fl); }
        else { float* rope = (float*)(p.ws + OFF_ROPE);
            for (int e = otid(); e < 1024; e += NTHREADS) { const int pos = e >> 4, i = e & 15;
                const float inv = exp2f(-(float)i * 0.830482023721841f);
                const float ang = (float)pos * inv; float sn, cs; sincosf(ang, &sn, &cs);
                rope[2 * e] = cs; rope[2 * e + 1] = sn; } }
    }
}

__device__ __forceinline__ void phase_mod0(const Params& p) {
    const int tid = otid(), G = gridDim.x, blk = blockIdx.x;
    const float* MODP = (const float*)(p.ws + OFF_MODP); float* MODF = (float*)(p.ws + OFF_MODF);
    bf16_t* H = (bf16_t*)(p.ws + OFF_HY);
    for (int idx = blk * NTHREADS + tid; idx < 2 * 5 * 6144; idx += G * NTHREADS) {
        const int l = idx / 30720, rem = idx % 30720, r = rem / 6144, n = rem % 6144; float v = p.b_mod[l * 6144 + n];
#pragma unroll
        for (int kq = 0; kq < 4; ++kq) v += MODP[(size_t)((l * 4 + kq) * 5 + r) * 6144 + n];
        MODF[idx] = v; }
    const int per = (MROWS + G - 1) / G; int r0 = blk * per, r1 = r0 + per; if (r1 > MROWS) r1 = MROWS;
    const int col = 4 * tid;
    while (r0 < r1) {
        const int b = r0 < NLAT ? r0 / SEQ : 4; int rend = r0 < NLAT ? (b + 1) * SEQ : MROWS; if (rend > r1) rend = r1;
        f32x4 sh = *(const f32x4*)(p.b_mod + col), sc = *(const f32x4*)(p.b_mod + 2048 + col);
#pragma unroll
        for (int kq = 0; kq < 4; ++kq) { sh += *(const f32x4*)(MODP + (size_t)(kq * 5 + b) * 6144 + col); sc += *(const f32x4*)(MODP + (size_t)(kq * 5 + b) * 6144 + 2048 + col); }
        sc += 1.f;
#pragma unroll 4
        for (int row = r0; row < rend; ++row) {
            const float* src = row < NLAT ? p.x + (size_t)row * DM : p.ctx + (size_t)(row - NLAT) * DM;
            const f32x4 v = *(const f32x4*)(src + col); const f32x4 h = v * sc + sh;
            u32x2 w; w.x = pk2(h[0], h[1]); w.y = pk2(h[2], h[3]); *(u32x2*)(H + (size_t)row * DM + col) = w; }
        r0 = rend;
    }
}

struct OrderX {
    pg8::StaticOrder base; int nextra, epm0, epn0, epnn;
    __device__ __forceinline__ bool next(int i, pg8::Unit& u) const {
        const long L = (long)i * base.G + base.c; if (L < base.nwg) return base.next(i, u);
        const int e = (int)(L - base.nwg); if (e >= nextra) return false; u.pm = epm0 + e / epnn; u.pn = epn0 + e % epnn; return true; }
    __device__ __forceinline__ void a_ready(const pg8::Unit&) const {}
    __device__ __forceinline__ void done(const pg8::Unit&) const {}
};

struct EpiIn {
    static constexpr bool PERM = true, AFTER_DRAIN = false;
    bf16_t* P; const float* rope;
    __device__ __forceinline__ void operator()(const f32x4 (&acc)[2][2][4][2], const pg8::Unit& u, int wr, int wc, int fr, int fq) const {
        const bool isq = (u.pn >= 8 && u.pn < 12), isk = (u.pn >= 12 && u.pn < 16);
        const bool dorope = (isq || isk) && (u.pm < 64);
        const float qs = isq ? QSCALE : 1.f;
#pragma unroll
        for (int ai = 0; ai < 2; ++ai)
#pragma unroll
            for (int m = 0; m < 4; ++m) {
                const int row = u.pm * 256 + ai * 128 + wr * 64 + m * 16 + fr; const int t = row & 4095, prow = t >> 6, pcol = t & 63;
#pragma unroll
                for (int bj = 0; bj < 2; ++bj) {
                    const int col0 = u.pn * 256 + bj * 128 + wc * 32 + 8 * fq;
                    f32x4 v0 = acc[ai][bj][m][0], v1 = acc[ai][bj][m][1];
                    if (dorope) { const int part = (col0 >> 5) & 1, i0 = (col0 & 31) >> 1, pos = part ? pcol : prow; const float* rp = rope + (pos * 16 + i0) * 2;
                        const f32x4 c0 = *(const f32x4*)rp, c1 = *(const f32x4*)(rp + 4); float a, b;
                        a = v0[0]; b = v0[1]; v0[0] = a * c0[0] - b * c0[1]; v0[1] = a * c0[1] + b * c0[0];
                        a = v0[2]; b = v0[3]; v0[2] = a * c0[2] - b * c0[3]; v0[3] = a * c0[3] + b * c0[2];
                        a = v1[0]; b = v1[1]; v1[0] = a * c1[0] - b * c1[1]; v1[1] = a * c1[1] + b * c1[0];
                        a = v1[2]; b = v1[3]; v1[2] = a * c1[2] - b * c1[3]; v1[3] = a * c1[3] + b * c1[2]; }
                    v0 = v0 * qs; v1 = v1 * qs;
                    u32x4 w; w.x = pk2(v0[0], v0[1]); w.y = pk2(v0[2], v0[3]); w.z = pk2(v1[0], v1[1]); w.w = pk2(v1[2], v1[3]);
                    *(u32x4*)(P + (size_t)row * DIN + col0) = w; } }
    }
};

struct EpiOut {
    static constexpr bool PERM = true, AFTER_DRAIN = false;
    const float* xlat; const float* xctx; float* olat; float* octx; const float* gate;
    const float* stats; const float* lg; const float* lb;
    __device__ __forceinline__ void operator()(const f32x4 (&acc)[2][2][4][2], const pg8::Unit& u, int wr, int wc, int fr, int fq) const {
        const bool lat = u.pm < 64;
#pragma unroll
        for (int ai = 0; ai < 2; ++ai)
#pragma unroll
            for (int m = 0; m < 4; ++m) {
                const int row = u.pm * 256 + ai * 128 + wr * 64 + m * 16 + fr; const int b = lat ? (row >> 12) : 4;
                const float* xr = lat ? xlat + (size_t)row * DM : xctx + (size_t)(row - NLAT) * DM;
                float* orow = lat ? olat + (size_t)row * DM : octx + (size_t)(row - NLAT) * DM;
                const float* gr = gate + b * 6144;
                float mean = 0.f, rstd = 1.f; if (stats) { mean = stats[2 * row]; rstd = stats[2 * row + 1]; }
#pragma unroll
                for (int bj = 0; bj < 2; ++bj) {
                    const int col0 = u.pn * 256 + bj * 128 + wc * 32 + 8 * fq;
                    const f32x4 g0 = *(const f32x4*)(gr + col0), g1 = *(const f32x4*)(gr + col0 + 4);
                    f32x4 x0 = *(const f32x4*)(xr + col0), x1 = *(const f32x4*)(xr + col0 + 4);
                    if (stats) { x0 = (x0 - mean) * rstd * *(const f32x4*)(lg + col0) + *(const f32x4*)(lb + col0); x1 = (x1 - mean) * rstd * *(const f32x4*)(lg + col0 + 4) + *(const f32x4*)(lb + col0 + 4); }
                    const f32x4 z0 = x0 * ALPHA + g0 * acc[ai][bj][m][0], z1 = x1 * ALPHA + g1 * acc[ai][bj][m][1];
                    *(f32x4*)(orow + col0) = z0; *(f32x4*)(orow + col0 + 4) = z1; } }
    }
};

namespace att {
constexpr int SHM_V = 16384, SHM_K = 8192, NSLOT = 3;
constexpr int LDS_K = 0, LDS_V = NSLOT * SHM_K, LDS_WS = LDS_V + NSLOT * SHM_V, LDS_TOTAL = LDS_WS + 8 * 64 * 4;
constexpr float THRL = 8.f;
#ifdef ATT_TEST_RARE
constexpr float FIRST_THR = 1.0f, SUM_THR = 64.f;
#else
constexpr float FIRST_THR = 40.f, SUM_THR = 16777216.f;
#endif
#define KSW(row, chunk) ((row) * 128 + ((((chunk) ^ (((row) >> 1) & 7))) << 4))
#define SBAR() __builtin_amdgcn_sched_barrier(0)
__device__ __forceinline__ int crow(int r, int hi) { return (r & 3) + 8 * (r >> 2) + 4 * hi; }
__device__ __forceinline__ unsigned cvtpk(float lo, float hi) { unsigned r; asm volatile("v_cvt_pk_bf16_f32 %0, %1, %2" : "=v"(r) : "v"(lo), "v"(hi)); return r; }

__device__ __forceinline__ float max3f(float a, float b, float c) { float r; asm("v_max3_f32 %0, %1, %2, %3" : "=v"(r) : "v"(a), "v"(b), "v"(c)); return r; }
template <bool FIRST, int VAR = 0>
__device__ __forceinline__ void partialSM(f32x16& p0, f32x16& p1, float& mref) {
    if (FIRST) {
        float pmax = max3f(p0[0], p0[1], p1[0]); pmax = max3f(pmax, p1[1], p0[2]);
#pragma unroll
        for (int r = 2; r < 16; r += 2) { pmax = max3f(pmax, p1[r], p1[r + 1]); if (r + 2 < 16) pmax = max3f(pmax, p0[r + 1], p0[r + 2]); else pmax = fmaxf(pmax, p0[r + 1]); }
        { auto rr = __builtin_amdgcn_permlane32_swap(__float_as_uint(pmax), __float_as_uint(pmax), false, false);
          pmax = fmaxf(__uint_as_float(rr[0]), __uint_as_float(rr[1])); }
        mref = __any(fabsf(pmax) > FIRST_THR) ? pmax : 0.f;
    }
    if (__builtin_expect(__any(mref != 0.f), 0)) { const float mn = mref;
#pragma unroll
        for (int r = 0; r < 16; ++r) p0[r] -= mn; }
#pragma unroll
    for (int r = 0; r < 16; ++r) p0[r] = (VAR & 1) ? p0[r] * 0.001f : __builtin_amdgcn_exp2f(p0[r]);
}
template <int VAR = 0>
__device__ __forceinline__ float finishSM(f32x16& p0, f32x16& p1, float& mref, float& l_reg, bf16x8& pa0, bf16x8& pa1, bf16x8& pa2, bf16x8& pa3) {
    if (__builtin_expect(__any(mref != 0.f), 0)) { const float mn = mref;
#pragma unroll
        for (int r = 0; r < 16; ++r) p1[r] -= mn; }
#pragma unroll
    for (int r = 0; r < 16; ++r) p1[r] = (VAR & 1) ? p1[r] * 0.001f : __builtin_amdgcn_exp2f(p1[r]);
    float ps = 0;
#pragma unroll
    for (int r = 0; r < 16; ++r) ps += p0[r];
#pragma unroll
    for (int r = 0; r < 16; ++r) ps += p1[r];
    { auto rr = __builtin_amdgcn_permlane32_swap(__float_as_uint(ps), __float_as_uint(ps), false, false);
      ps = __uint_as_float(rr[0]) + __uint_as_float(rr[1]); }
    float f = 1.f;
    if (__builtin_expect(__any(ps > SUM_THR), 0)) {
        if (ps > SUM_THR) { const int e = ((__float_as_uint(ps) >> 23) & 0xff) - 127; f = __uint_as_float((unsigned)(127 - e) << 23); mref += (float)e; }
#pragma unroll
        for (int r = 0; r < 16; ++r) { p0[r] *= f; p1[r] *= f; }
        ps *= f; l_reg *= f;
    }
    l_reg += ps;
#define PK4(P, BASE, OUT) do { u32x4 w = {cvtpk(P[BASE + 0], P[BASE + 1]), cvtpk(P[BASE + 2], P[BASE + 3]), cvtpk(P[BASE + 4], P[BASE + 5]), cvtpk(P[BASE + 6], P[BASE + 7])}; \
    OUT = *reinterpret_cast<bf16x8*>(&w); } while (0)
    PK4(p0, 0, pa0); PK4(p0, 8, pa1); PK4(p1, 0, pa2); PK4(p1, 8, pa3);
#undef PK4
    return f;
}
__device__ __forceinline__ void qkt(f32x16& p0, f32x16& p1, const LAS char* Ks, const bf16x8* qr, int r32, int hi) {
#pragma unroll
    for (int d0 = 0; d0 < 4; ++d0) { const int ch = d0 * 2 + hi;
        bf16x8 b0 = *(const LAS bf16x8*)(Ks + KSW(r32, ch));
        bf16x8 b1 = *(const LAS bf16x8*)(Ks + KSW(32 + r32, ch));
        if (d0 == 0) { p0 = __builtin_amdgcn_mfma_f32_32x32x16_bf16(b0, qr[0], f32x16{}, 0, 0, 0); p1 = __builtin_amdgcn_mfma_f32_32x32x16_bf16(b1, qr[0], f32x16{}, 0, 0, 0); }
        else { p0 = __builtin_amdgcn_mfma_f32_32x32x16_bf16(b0, qr[d0], p0, 0, 0, 0); p1 = __builtin_amdgcn_mfma_f32_32x32x16_bf16(b1, qr[d0], p1, 0, 0, 0); } }
}
__device__ __forceinline__ int v_st(int k, int c) { const int kk = (k & ~0xC) | ((k & 4) << 1) | ((k & 8) >> 1); return ((kk >> 3) * 4 + (c >> 5)) * 512 + ((kk & 7) * 32 + (c & 31)) * 2; }
__device__ __forceinline__ int v_rd_base(int lane) { return ((lane & 3) << 3) | (((lane >> 2) & 3) << 6) | (((lane >> 4) & 1) << 5) | (((lane >> 5) & 1) << 8); }
constexpr int v_rd_off(int d0, int ks, int half) { return d0 * 512 + ks * 4096 + half * 2048; }
template <int OFF> __device__ __forceinline__ s16x4 tr_read(int vb) {
    s16x4 r; asm volatile("ds_read_b64_tr_b16 %0, %1 offset:%2" : "=&v"(r) : "v"(vb), "i"(OFF) : "memory"); return r;
}
#define RD8(KS, X) const s16x4 X##0 = tr_read<v_rd_off(0, KS, 0)>(vb), X##1 = tr_read<v_rd_off(0, KS, 1)>(vb), X##2 = tr_read<v_rd_off(1, KS, 0)>(vb), X##3 = tr_read<v_rd_off(1, KS, 1)>(vb), \
    X##4 = tr_read<v_rd_off(2, KS, 0)>(vb), X##5 = tr_read<v_rd_off(2, KS, 1)>(vb), X##6 = tr_read<v_rd_off(3, KS, 0)>(vb), X##7 = tr_read<v_rd_off(3, KS, 1)>(vb)
#define WDEP(N, X) s16x4 X##w0 = X##0, X##w1 = X##1, X##w2 = X##2, X##w3 = X##3, X##w4 = X##4, X##w5 = X##5, X##w6 = X##6, X##w7 = X##7; \
    asm volatile("s_waitcnt lgkmcnt(" #N ")" : "+v"(X##w0), "+v"(X##w1), "+v"(X##w2), "+v"(X##w3), "+v"(X##w4), "+v"(X##w5), "+v"(X##w6), "+v"(X##w7) :: "memory")
#define PKV(L, H) (bf16x8){L[0], L[1], L[2], L[3], H[0], H[1], H[2], H[3]}
#define MM4(pa, X) o[0] = __builtin_amdgcn_mfma_f32_32x32x16_bf16(pa, PKV(X##w0, X##w1), o[0], 0, 0, 0); o[1] = __builtin_amdgcn_mfma_f32_32x32x16_bf16(pa, PKV(X##w2, X##w3), o[1], 0, 0, 0); \
    o[2] = __builtin_amdgcn_mfma_f32_32x32x16_bf16(pa, PKV(X##w4, X##w5), o[2], 0, 0, 0); o[3] = __builtin_amdgcn_mfma_f32_32x32x16_bf16(pa, PKV(X##w6, X##w7), o[3], 0, 0, 0)
__device__ __forceinline__ void pv_d0(f32x16* o, int vb, bf16x8 pa0, bf16x8 pa1, bf16x8 pa2, bf16x8 pa3) {
    RD8(0, a);
    RD8(1, b); WDEP(8, a); MM4(pa0, a);
    RD8(2, c); WDEP(8, b); MM4(pa1, b);
    RD8(3, d); WDEP(8, c); MM4(pa2, c);
    WDEP(0, d); MM4(pa3, d);
}
#undef RD8
#undef WDEP
#undef PKV
#undef MM4

template <int VAR>
__device__ __forceinline__ void attn_map(const bf16_t* __restrict__ Qw, const bf16_t* __restrict__ Kc, const bf16_t* __restrict__ Vc, int ctx_row0, int lat_row0, int nct, int NT,
                                         LAS char* lds, f32x16 (&o)[4], float& l_out) {
    const int tid = otid(), wid = __builtin_amdgcn_readfirstlane(tid >> 6), lane = tid & 63, r32 = lane & 31, hi = lane >> 5;
    LAS char* V_lds = lds + LDS_V; LAS char* K_lds = lds + LDS_K;
    LAS float* ws = (LAS float*)(lds + LDS_WS) + wid * 64; LAS float* al_l = ws + 32;
    float m_reg = 0.f, l_reg = 0;
#pragma unroll
    for (int d = 0; d < 4; ++d) o[d] = f32x16{};
    const int krow = wid * 8 + (lane >> 3), kchunk = (lane & 7) ^ ((krow >> 1) & 7);
    const bf16_t* ksrc = Kc + (size_t)krow * DIN + kchunk * 8;
    const int kkey = wid * 8 + ((lane & 31) >> 2);
    const bf16_t* vsrc0 = Vc + (size_t)kkey * DIN + hi * 32 + (lane & 3) * 8;
    const int vb0 = (int)(uintptr_t)V_lds + v_rd_base(lane);
#define KROW(t) (((t) < nct) ? (ctx_row0 + (t) * 64) : (lat_row0 + ((t) - nct) * 64))
#define DMA(t, slot) do { const size_t ro_ = (size_t)KROW(t) * DIN; \
    __builtin_amdgcn_global_load_lds((const unsigned*)(ksrc + ro_), (LAS unsigned*)(K_lds + (slot) * SHM_K + wid * 1024), 16, 0, 0); \
    __builtin_amdgcn_global_load_lds((const unsigned*)(vsrc0 + ro_), (LAS unsigned*)(V_lds + (slot) * SHM_V + wid * 2048), 16, 0, 0); \
    __builtin_amdgcn_global_load_lds((const unsigned*)(vsrc0 + ro_ + 64), (LAS unsigned*)(V_lds + (slot) * SHM_V + wid * 2048 + 1024), 16, 0, 0); } while (0)
#define WAIT_BAR(N) asm volatile("s_waitcnt vmcnt(" #N ") lgkmcnt(0)\n\ts_barrier" ::: "memory")
#define RESC(a) do { if (__any((a) < 1.f)) { if (hi == 0) al_l[r32] = (a); asm volatile("s_waitcnt lgkmcnt(0)" ::: "memory"); \
    _Pragma("unroll") for (int d = 0; d < 4; ++d) _Pragma("unroll") for (int r = 0; r < 16; ++r) o[d][r] *= al_l[crow(r, hi)]; } } while (0)
#define STEP(C0, C1, alC, P0, P1, alP, t, GD) do { WAIT_BAR(0); \
    if (GD && !(VAR & 2)) { DMA((t) + 1, sn); } SBAR(); \
    qkt(C0, C1, K_lds + sc_ * SHM_K, qr, r32, hi); \
    { const float f_ = finishSM<VAR>(P0, P1, m_reg, l_reg, pa0, pa1, pa2, pa3); RESC(f_); } SBAR(); \
    if (!(VAR & 4)) pv_d0(o, vb0 + sp * SHM_V, pa0, pa1, pa2, pa3); partialSM<false, VAR>(C0, C1, m_reg); \
    sp = sc_; sc_ = sn; sn = (sn == NSLOT - 1) ? 0 : sn + 1; } while (0)
    f32x16 pA0, pA1, pB0, pB1; const float alA = 1.f, alB = 1.f; bf16x8 pa0, pa1, pa2, pa3; (void)alA; (void)alB;
    WAIT_BAR(0);
    bf16x8 qr[4];
#pragma unroll
    for (int d0 = 0; d0 < 4; ++d0) qr[d0] = *reinterpret_cast<const bf16x8*>(Qw + d0 * 16);
    if (!(VAR & 2)) { DMA(0, 0); DMA(1, 1); }
    WAIT_BAR(3);
    qkt(pA0, pA1, K_lds, qr, r32, hi); partialSM<true, VAR>(pA0, pA1, m_reg);
    int sp = 0, sc_ = 1, sn = 2;
    for (int j = 1; j + 1 < NT; j += 2) {
        STEP(pB0, pB1, alB, pA0, pA1, alA, j, true);
        STEP(pA0, pA1, alA, pB0, pB1, alB, j + 1, true);
    }
    STEP(pB0, pB1, alB, pA0, pA1, alA, NT - 1, false);
    { const float f_ = finishSM<VAR>(pB0, pB1, m_reg, l_reg, pa0, pa1, pa2, pa3); RESC(f_); } SBAR();
    pv_d0(o, vb0 + sp * SHM_V, pa0, pa1, pa2, pa3);
    l_out = l_reg;
#undef KROW
#undef DMA
#undef WAIT_BAR
#undef RESC
#undef STEP
}

constexpr int LDS_OB = 0, LDS_OA = 81920, LDS_ATT_END = LDS_OA + 65536;
static_assert(LDS_TOTAL <= LDS_OA, "attention LDS map");
template <int VAR = 0>
__device__ __forceinline__ void attn_unit(const Params& p, int l, int h, int qrow0, int ctx_row0, int lat_row0, int nct, int NT, float lam, float oml, LAS char* lds, bf16_t* Y) {
    const int tid = otid(), wid = tid >> 6, lane = tid & 63, r32 = lane & 31, hi = lane >> 5;
    const bf16_t* P = (const bf16_t*)(p.ws + OFF_P);
    LAS float* li_l = (LAS float*)(lds + LDS_WS) + wid * 64;
    f32x16 o[4]; float l_reg;
#ifndef MPN
#define MPN 2
#endif
#pragma unroll
    for (int mp = 0; mp < MPN; ++mp) {
        const bf16_t* Qw = P + (size_t)(qrow0 + wid * 32 + r32) * DIN + C_Q + h * 128 + mp * 64 + hi * 8;
        attn_map<VAR>(Qw, P + C_K + h * 128 + mp * 64, P + C_V + h * 128, ctx_row0, lat_row0, nct, NT, lds, o, l_reg);
        if (hi == 0) li_l[r32] = l_reg; asm volatile("s_waitcnt lgkmcnt(0)" ::: "memory");
        float rli[16];
#pragma unroll
        for (int r = 0; r < 16; ++r) rli[r] = __builtin_amdgcn_rcpf(li_l[crow(r, hi)]);
        if (mp == 1) __syncthreads();
        LAS bf16_t* ol = (LAS bf16_t*)(lds + (mp == 0 ? LDS_OA : LDS_OB)) + (wid * 32 + 4 * hi) * 128 + r32;
#pragma unroll
        for (int r = 0; r < 16; ++r)
#pragma unroll
            for (int d0 = 0; d0 < 4; ++d0) ol[((r & 3) + 8 * (r >> 2)) * 128 + d0 * 32] = (bf16_t)(cvtpk(o[d0][r] * rli[r], 0.f) & 0xffffu);
        if (mp == 1) {
            asm volatile("s_waitcnt lgkmcnt(0)" ::: "memory");
            int c4 = r32 * 4; asm volatile("" : "+v"(c4));
            const f32x4 g4 = *(const f32x4*)(p.subln_g + l * 128 + c4) * oml;
            const LAS bf16_t* A = (const LAS bf16_t*)(lds + LDS_OA) + (wid * 32 + hi) * 128 + c4;
            const LAS bf16_t* B = (const LAS bf16_t*)(lds + LDS_OB) + (wid * 32 + hi) * 128 + c4;
            const bf16_t* agp = P + (size_t)(qrow0 + wid * 32 + hi) * DIN + C_AG + h * 128 + c4;
            bf16_t* yp = Y + (size_t)(qrow0 + wid * 32 + hi) * DM + 512 + h * 128 + c4;
#pragma unroll 2
            for (int st = 0; st < 16; ++st) {
                const u32x2 av = *(const LAS u32x2*)(A + st * 256), bv = *(const LAS u32x2*)(B + st * 256);
                const u32x2 ag = *(const u32x2*)(agp + (size_t)(st * 2) * DIN);
                const float f0 = bflo(av.x) - lam * bflo(bv.x), f1 = bfhi(av.x) - lam * bfhi(bv.x), f2 = bflo(av.y) - lam * bflo(bv.y), f3 = bfhi(av.y) - lam * bfhi(bv.y);
                float ss = (f0 * f0 + f1 * f1) + (f2 * f2 + f3 * f3);
#pragma unroll
                for (int off = 1; off < 32; off <<= 1) ss += __shfl_xor(ss, off);
                const float rstd = __builtin_amdgcn_rsqf(ss * (1.f / 128.f) + RMS_EPS);
                const float y0 = f0 * rstd * g4[0] * silu_f(bflo(ag.x)), y1 = f1 * rstd * g4[1] * silu_f(bfhi(ag.x));
                const float y2 = f2 * rstd * g4[2] * silu_f(bflo(ag.y)), y3 = f3 * rstd * g4[3] * silu_f(bfhi(ag.y));
                u32x2 w; w.x = cvtpk(y0, y1); w.y = cvtpk(y2, y3);
                *(u32x2*)(yp + (size_t)(st * 2) * DM) = w;
            }
        }
    }
}
#undef KSW
#undef SBAR
}

__device__ __forceinline__ void seq_bounds(int R0, int& s0, int& s1) { if (R0 < NLAT) { s0 = R0 & ~(SEQ - 1); s1 = s0 + SEQ; } else { s0 = NLAT + ((R0 - NLAT) & ~(CTXL - 1)); s1 = s0 + CTXL; } }

__device__ __forceinline__ void unpack8(const u32x4 w, float (&f)[8]) { f[0] = bflo(w.x); f[1] = bfhi(w.x); f[2] = bflo(w.y); f[3] = bfhi(w.y); f[4] = bflo(w.z); f[5] = bfhi(w.z); f[6] = bflo(w.w); f[7] = bfhi(w.w); }

__device__ __forceinline__ void conv_item(const Params& p, int l, int rt) {
    const int tid = otid(), ch0 = (tid & 63) * 8, R0 = rt * 64, r0 = R0 + (tid >> 6) * 8; int s0, s1; seq_bounds(R0, s0, s1);
    const bf16_t* P = (const bf16_t*)(p.ws + OFF_P); bf16_t* Y = (bf16_t*)(p.ws + OFF_HY);
    const float* cw = p.conv_w + l * 3 * 512 + ch0;
    float w0[8], w1[8], w2[8];
#pragma unroll
    for (int j = 0; j < 8; ++j) { w0[j] = cw[j]; w1[j] = cw[512 + j]; w2[j] = cw[1024 + j]; }
#define LD16(row, sect) (*(const u32x4*)(P + (size_t)(row) * DIN + (sect) * 512 + ch0))
#pragma unroll 1
    for (int hb = 0; hb < 2; ++hb) {
        const int rb = r0 + hb * 4;
        u32x4 uu[6], cc[6], bb[4], gg[4];
#pragma unroll
        for (int i = 0; i < 6; ++i) { int rr = rb - 1 + i; rr = rr < s0 ? s0 : (rr >= s1 ? s1 - 1 : rr); uu[i] = LD16(rr, 0); cc[i] = LD16(rr, 2); }
#pragma unroll
        for (int i = 0; i < 4; ++i) { bb[i] = LD16(rb + i, 1); gg[i] = LD16(rb + i, 3); }
        float v[6][8];
#pragma unroll
        for (int i = 0; i < 6; ++i) { const int rr = rb - 1 + i; const float mk = (rr >= s0 && rr < s1) ? 1.f : 0.f; float a[8], c[8]; unpack8(uu[i], a); unpack8(cc[i], c);
#pragma unroll
            for (int j = 0; j < 8; ++j) v[i][j] = a[j] * c[j] * mk; }
#pragma unroll
        for (int i = 0; i < 4; ++i) { float a[8], g8[8], y[8]; unpack8(bb[i], a); unpack8(gg[i], g8);
#pragma unroll
            for (int j = 0; j < 8; ++j) y[j] = silu_f(g8[j]) * a[j] * (w0[j] * v[i][j] + w1[j] * v[i + 1][j] + w2[j] * v[i + 2][j]);
            u32x4 w; w.x = pk2(y[0], y[1]); w.y = pk2(y[2], y[3]); w.z = pk2(y[4], y[5]); w.w = pk2(y[6], y[7]);
            *(u32x4*)(Y + (size_t)(rb + i) * DM + ch0) = w; }
    }
#undef LD16
}

__device__ __forceinline__ void pool_block(const Params& p, int l, int g, int rt0, int rt_step, int nrt, LAS unsigned char* lds) {
    const int tid = otid();
    const bf16_t* P = (const bf16_t*)(p.ws + OFF_P); bf16_t* Y = (bf16_t*)(p.ws + OFF_HY);
    LAS bf16_t* ut = (LAS bf16_t*)lds;
    LAS bf16_t* dt = ut + 80 * 136;
    LAS bf16_t* wt = dt + 64 * 136;
    LAS float* st = (LAS float*)(wt + 128 * 136);
    if (rt0 >= nrt) return;
    { const bf16_t* PWT = (const bf16_t*)(p.ws + OFF_PWT) + (size_t)(l * 4 + g) * 128 * 128;
      for (int c = tid; c < 2048; c += NTHREADS) { const int row = c >> 4, ch = c & 15; *(LAS u32x4*)(wt + row * 136 + ch * 8) = *(const u32x4*)(PWT + row * 128 + ch * 8); } }
    const int erow = tid >> 4, ech = (tid & 15) * 8;
    float sc8[8];
#pragma unroll
    for (int j = 0; j < 8; ++j) sc8[j] = p.pool_scale[l * 512 + g * 128 + ech + j];
#define ULOAD(rt_, A, B, C) do { const int R0_ = (rt_) * 64; int s0_, s1_; seq_bounds(R0_, s0_, s1_); \
    { const int c = tid, row = c >> 4, ch = c & 15, gr = R0_ - 8 + row; A = (u32x4){0u, 0u, 0u, 0u}; if (gr >= s0_ && gr < s1_) A = *(const u32x4*)(P + (size_t)gr * DIN + C_PU + g * 128 + ch * 8); } \
    { const int c = tid + 512, row = c >> 4, ch = c & 15, gr = R0_ - 8 + row; B = (u32x4){0u, 0u, 0u, 0u}; if (gr >= s0_ && gr < s1_) B = *(const u32x4*)(P + (size_t)gr * DIN + C_PU + g * 128 + ch * 8); } \
    { const int c = tid + 1024, row = c >> 4, ch = c & 15, gr = R0_ - 8 + row; C = (u32x4){0u, 0u, 0u, 0u}; if (tid < 256 && gr >= s0_ && gr < s1_) C = *(const u32x4*)(P + (size_t)gr * DIN + C_PU + g * 128 + ch * 8); } } while (0)
    u32x4 ua, ub, uc; ULOAD(rt0, ua, ub, uc);
    for (int rt = rt0; rt < nrt; rt += rt_step) {
        const int R0 = rt * 64; int s0, s1; seq_bounds(R0, s0, s1);
        *(LAS u32x4*)(ut + (tid >> 4) * 136 + (tid & 15) * 8) = ua; *(LAS u32x4*)(ut + ((tid + 512) >> 4) * 136 + (tid & 15) * 8) = ub;
        if (tid < 256) *(LAS u32x4*)(ut + ((tid + 1024) >> 4) * 136 + (tid & 15) * 8) = uc;
        const u32x4 pg0 = *(const u32x4*)(P + (size_t)(R0 + erow) * DIN + C_PG + g * 128 + ech), pg1 = *(const u32x4*)(P + (size_t)(R0 + erow + 32) * DIN + C_PG + g * 128 + ech);
        if (rt + rt_step < nrt) ULOAD(rt + rt_step, ua, ub, uc);
        __syncthreads();
        { const int cp = tid & 63, rg = tid >> 6, hw = 1 << g, t0 = R0 + rg * 8;
#define LDU(lrow) (*(const LAS unsigned*)(ut + (lrow) * 136 + 2 * cp))
          float a0 = 0.f, a1 = 0.f;
          for (int j = -hw; j < hw; ++j) { const unsigned u = LDU(rg * 8 + 8 + j); a0 += bflo(u); a1 += bfhi(u); }
#pragma unroll
          for (int i = 0; i < 8; ++i) { const int t = t0 + i, lr = rg * 8 + 8 + i; const int lo_t = (t - hw < s0) ? s0 : t - hw, hi_t = (t + hw > s1) ? s1 : t + hw;
              const float inv = 1.f / (float)(hi_t - lo_t); const unsigned u = LDU(lr);
              *(LAS unsigned*)(dt + (rg * 8 + i) * 136 + 2 * cp) = pk2(a0 * inv - bflo(u), a1 * inv - bfhi(u));
              const unsigned un = LDU(lr + hw), uo = LDU(lr - hw);
              a0 += bflo(un) - bflo(uo); a1 += bfhi(un) - bfhi(uo); }
#undef LDU
        }
        __syncthreads();
        { const int wid = tid >> 6, lane = tid & 63, mt = wid & 3, nh = wid >> 2, fr = lane & 15, fq = lane >> 4;
          f32x4 acc[4];
#pragma unroll
          for (int n = 0; n < 4; ++n) acc[n] = (f32x4){0.f, 0.f, 0.f, 0.f};
#pragma unroll
          for (int ks = 0; ks < 4; ++ks) { const bf16x8 a = *(const LAS bf16x8*)(dt + (mt * 16 + fr) * 136 + ks * 32 + fq * 8);
#pragma unroll
              for (int n = 0; n < 4; ++n) { const bf16x8 b = *(const LAS bf16x8*)(wt + (nh * 64 + n * 16 + fr) * 136 + ks * 32 + fq * 8);
                  acc[n] = __builtin_amdgcn_mfma_f32_16x16x32_bf16(a, b, acc[n], 0, 0, 0); } }
#pragma unroll
          for (int n = 0; n < 4; ++n)
#pragma unroll
              for (int j = 0; j < 4; ++j) st[(mt * 16 + 4 * fq + j) * 132 + nh * 64 + n * 16 + fr] = acc[n][j]; }
        __syncthreads();
#pragma unroll
        for (int h2 = 0; h2 < 2; ++h2) { const int row = erow + 32 * h2; float gv[8]; unpack8(h2 ? pg1 : pg0, gv);
            const f32x4 x0 = *(const LAS f32x4*)(st + row * 132 + ech), x1 = *(const LAS f32x4*)(st + row * 132 + ech + 4);
            float y[8];
#pragma unroll
            for (int j = 0; j < 8; ++j) y[j] = silu_f(gv[j]) * sc8[j] * (j < 4 ? x0[j] : x1[j - 4]);
            u32x4 w; w.x = pk2(y[0], y[1]); w.y = pk2(y[2], y[3]); w.z = pk2(y[4], y[5]); w.w = pk2(y[6], y[7]);
            *(u32x4*)(Y + (size_t)(R0 + row) * DM + 1536 + g * 128 + ech) = w; }
    }
#undef ULOAD
    __syncthreads();
}

__device__ __forceinline__ void phase_mix(const Params& p, int l, LAS unsigned char* lds) {
    const int G = gridDim.x, blk = blockIdx.x, lane = otid() & 63;
    const float lam_init = (l == 0) ? 0.2f : 0.35550906759096935f;
    float lam;
    { const float a = p.lq1[l * 64 + lane] * p.lk1[l * 64 + lane], b = p.lq2[l * 64 + lane] * p.lk2[l * 64 + lane];
      lam = __expf(wave_sum(a)) - __expf(wave_sum(b)) + lam_init; }
    const int nrt = (l == 0) ? MROWS / 64 : NLAT / 64;
    const int n_conv = nrt, n_pool = nrt * 4, n_cattn = (l == 0) ? 32 : 0;
    {
        const int skip = (l == 0 && G == 256) ? 32 : 0, vb = blk - skip, nvb = G - skip;
        if (vb >= 0) {
            for (int it = vb; it < n_conv; it += nvb) conv_item(p, l, it);
            if ((nvb & 3) == 0) pool_block(p, l, vb & 3, vb >> 2, nvb >> 2, nrt, lds); else for (int g4 = 0; g4 < 4; ++g4) pool_block(p, l, g4, vb, nvb, nrt, lds);
        }
    }
#ifdef PROBE_CP2
    for (int it = blk; it < n_conv; it += G) conv_item(p, l, it);
    if ((G & 3) == 0) pool_block(p, l, blk & 3, blk >> 2, G >> 2, nrt, lds); else for (int g4 = 0; g4 < 4; ++g4) pool_block(p, l, g4, blk, G, nrt, lds);
#endif
#ifndef NO_LATTN
    for (int u = blk; u < 512 + n_cattn; u += G) {
        int h, qrow0, crow0, lrow0, NT;
        if (u < 512) {
            int bh, qb;
            if (G == 256) { const int i = u >> 8, xcd = blk & 7, j = blk >> 3; bh = xcd * 4 + i * 2 + (j >> 4); qb = j & 15; }
            else { bh = u >> 4; qb = u & 15; }
            const int b = bh >> 3; h = bh & 7; qrow0 = b * SEQ + qb * 256; crow0 = NLAT + b * CTXL; lrow0 = b * SEQ; NT = 68;
        } else { const int q = u - 512, b = q >> 3; h = q & 7; qrow0 = NLAT + b * CTXL; crow0 = qrow0; lrow0 = qrow0; NT = 4; }
        att::attn_unit<0>(p, l, h, qrow0, crow0, lrow0, 4, NT, lam, 1.f - lam_init, (LAS char*)lds, (bf16_t*)(p.ws + OFF_HY));
    }
#endif
#ifdef PROBE_ATT
    if (l == 0) for (int u = blk; u < 512; u += G) {
        int bh, qb; if (G == 256) { const int i = u >> 8, xcd = blk & 7, j = blk >> 3; bh = xcd * 4 + i * 2 + (j >> 4); qb = j & 15; } else { bh = u >> 4; qb = u & 15; }
        const int b = bh >> 3, h = bh & 7;
        att::attn_unit<PROBE_ATT - 1>(p, l, h, b * SEQ + qb * 256, NLAT + b * CTXL, b * SEQ, 4, 68, lam, 1.f - lam_init, (LAS char*)lds, (bf16_t*)(p.ws + WS_END));
    }
#endif
    __syncthreads();
}

__device__ __forceinline__ void phase_ln(const Params& p, int l, bool final, int row_lo, int row_hi, int vb, int nvb) {
    const int tid = otid(), wid = tid >> 6, lane = tid & 63;
    const float* MODF = (const float*)(p.ws + OFF_MODF); bf16_t* H = (bf16_t*)(p.ws + OFF_HY);
    const float* lg = p.ln_g + l * DM; const float* lb = p.ln_b + l * DM;
    for (int row = row_lo + vb * 8 + wid; row < row_hi; row += nvb * 8) {
        const bool lat = row < NLAT;
        float* src = lat ? p.out + (size_t)row * DM : (float*)(p.ws + OFF_ZC) + (size_t)(row - NLAT) * DM;
        f32x4 v[8]; float s = 0.f;
#pragma unroll
        for (int i = 0; i < 8; ++i) { v[i] = *(const f32x4*)(src + (i * 64 + lane) * 4); s += (v[i][0] + v[i][1]) + (v[i][2] + v[i][3]); }
        const float mean = wave_sum(s) * (1.f / DM); float q = 0.f;
#pragma unroll
        for (int i = 0; i < 8; ++i) { const f32x4 d = v[i] - mean; q += (d[0] * d[0] + d[1] * d[1]) + (d[2] * d[2] + d[3] * d[3]); }
        const float rstd = __builtin_amdgcn_rsqf(wave_sum(q) * (1.f / DM) + LN_EPS);
        const int b = lat ? (row >> 12) : 4;
        if (lat && !final && lane == 0) { float* stp = (float*)(p.ws + OFF_O1) + 2 * row; stp[0] = mean; stp[1] = rstd; }
#pragma unroll
        for (int i = 0; i < 8; ++i) { const int col = (i * 64 + lane) * 4;
            const f32x4 xn = (v[i] - mean) * rstd * *(const f32x4*)(lg + col) + *(const f32x4*)(lb + col);
            if (lat && final) *(f32x4*)(src + col) = xn;
            if (!final) { const f32x4 sh = *(const f32x4*)(MODF + (size_t)(5 + b) * 6144 + col), sc = *(const f32x4*)(MODF + (size_t)(5 + b) * 6144 + 2048 + col);
                const f32x4 h = xn * (sc + 1.f) + sh; u32x2 w; w.x = pk2(h[0], h[1]); w.y = pk2(h[2], h[3]); *(u32x2*)(H + (size_t)row * DM + col) = w; } }
    }
}

#define XB_TMO      128
#define XB_XCNT(j)  (256  + 64 * (j))
#define XB_XSUB(j)  (1280 + 64 * (j))
#define XB_XGEN(j)  (2304 + 64 * (j))
#define XB_TOP      3328
#define XB_TOPGEN   3392
#define XCD_BAR_WORDS 3456
#define XB_SPIN_CAP (1u << 18)

__device__ __forceinline__ unsigned xb_ld(unsigned* p)              { return __hip_atomic_load(p, __ATOMIC_RELAXED, __HIP_MEMORY_SCOPE_AGENT); }
__device__ __forceinline__ unsigned xb_add(unsigned* p, unsigned v) { return __hip_atomic_fetch_add(p, v, __ATOMIC_RELAXED, __HIP_MEMORY_SCOPE_AGENT); }
__device__ __forceinline__ unsigned xb_xcc_id() { return (unsigned)__builtin_amdgcn_s_getreg((3 << 11) | 20) & 0xFu; }
#define XB_SPIN(cond, bar) do { unsigned _sp = 0; while (cond) { __builtin_amdgcn_s_sleep(1); \
    if ((++_sp & 255u) == 0u) { if (xb_ld(&(bar)[XB_TMO])) break; if (_sp > XB_SPIN_CAP) { atomicAdd(&(bar)[XB_TMO], 1u); break; } } } } while (0)

struct XcdBarrier {
    unsigned* bar; unsigned x;
    volatile LAS unsigned* st;
};

__device__ __forceinline__ XcdBarrier xcd_barrier_post(unsigned* bar, volatile LAS unsigned* st) {
    XcdBarrier b; b.bar = bar; b.x = xb_xcc_id(); b.st = st;
    if (threadIdx.x == 0) (void)xb_add(&bar[XB_XCNT(b.x)], 1u);
    return b;
}
__device__ __forceinline__ void xcd_barrier_complete(unsigned* bar, unsigned x, unsigned& nloc, unsigned& nx) {
    const unsigned G = gridDim.x * gridDim.y * gridDim.z;
    unsigned sum, cnt, mine, sp = 0u;
    for (;;) {
        sum = 0u; cnt = 0u; mine = 0u;
#pragma unroll
        for (unsigned j = 0; j < 16; ++j) { const unsigned c = xb_ld(&bar[XB_XCNT(j)]); sum += c; cnt += (c > 0u) ? 1u : 0u; mine = (j == x) ? c : mine; }
        if (sum == G) break;
        __builtin_amdgcn_s_sleep(1);
        if ((++sp & 255u) == 0u) { if (xb_ld(&bar[XB_TMO])) break; if (sp > XB_SPIN_CAP) { atomicAdd(&bar[XB_TMO], 1u); break; } }
    }
    nloc = mine > 0u ? mine : 1u; nx = cnt > 0u ? cnt : 1u;
}

__device__ __forceinline__ void xcd_barrier(const XcdBarrier& b) {
    asm volatile("s_waitcnt vmcnt(0)" ::: "memory");
    __syncthreads();
    if (threadIdx.x == 0) {
        unsigned* bar = b.bar;
        __builtin_amdgcn_s_waitcnt(0);
        unsigned nloc = b.st[0], nx = b.st[1];
        if (nloc == 0u) { xcd_barrier_complete(bar, b.x, nloc, nx); b.st[0] = nloc; b.st[1] = nx; }
        const unsigned old = xb_add(&bar[XB_XSUB(b.x)], 1u);
        const unsigned gen = old / nloc;
        if (old + 1u == (gen + 1u) * nloc) {
            __builtin_amdgcn_fence(__ATOMIC_RELEASE, "agent");
            asm volatile("s_waitcnt vmcnt(0)" ::: "memory");
            const unsigned og = xb_add(&bar[XB_TOP], 1u);
            const unsigned tg = og / nx;
            if (og + 1u == (tg + 1u) * nx) xb_add(&bar[XB_TOPGEN], 1u);
            else XB_SPIN(xb_ld(&bar[XB_TOPGEN]) == tg, bar);
            __builtin_amdgcn_fence(__ATOMIC_ACQUIRE, "agent");
            xb_add(&bar[XB_XGEN(b.x)], 1u);
            asm volatile("s_waitcnt vmcnt(0)" ::: "memory");
        } else {
            XB_SPIN(xb_ld(&bar[XB_XGEN(b.x)]) == gen, bar);
            __builtin_amdgcn_fence(__ATOMIC_ACQUIRE, "agent");
            asm volatile("s_waitcnt vmcnt(0)" ::: "memory");
        }
    }
    __syncthreads();
}

__global__ void __launch_bounds__(NTHREADS, 2) hybrid_fwd(Params p) {
    extern __shared__ __attribute__((aligned(16))) unsigned char lds_g[];
    LAS unsigned char* lds = (LAS unsigned char*)lds_g;
    cg::grid_group grid = cg::this_grid();
    { volatile LAS unsigned* st0 = (volatile LAS unsigned*)(lds + 147456 + 64); if (threadIdx.x < 2) st0[threadIdx.x] = 0u; }
    __syncthreads();
    XcdBarrier xbar = xcd_barrier_post((unsigned*)p.ws, (volatile LAS unsigned*)(lds + 147456 + 64));
#define GSYNC() xcd_barrier(xbar)
    const int G = gridDim.x;

#ifndef PH_MASK
#define PH_MASK 0xFF
#endif
    if (gridDim.y == 0x7fffu) grid.sync();
    if constexpr (PH_MASK & 1) phase0(p, lds);
    GSYNC();
    if constexpr (PH_MASK & 2) phase_mod0(p);
    GSYNC();
#pragma unroll 1
    for (int l = 0; l < 2; ++l) {
        if constexpr (PH_MASK & 4) {
            pg8::Gemm g{(const bf16_t*)(p.ws + OFF_HY), (const bf16_t*)(p.ws + OFF_WTIN) + (size_t)l * DIN * DM, (l == 0) ? MROWS : NLAT, DIN, DM};
            OrderX S; S.base.init((l == 0) ? MROWS : NLAT, DIN, G, (int)blockIdx.x); S.nextra = (l == 0 || G == 256) ? 0 : 32; S.epm0 = 64; S.epn0 = 12; S.epnn = 8;
            EpiIn E{(bf16_t*)(p.ws + OFF_P), (const float*)(p.ws + OFF_ROPE)};
            pg8::gemm_phase<EpiIn, OrderX, true, true>(lds, g, S, E);
        }
        GSYNC();
        if constexpr (PH_MASK & 8) phase_mix(p, l, lds);
#ifdef PROBE_MIX2
        GSYNC(); phase_mix(p, l, lds);
#endif
        GSYNC();
        if constexpr (PH_MASK & 16) {
            pg8::Gemm g{(const bf16_t*)(p.ws + OFF_HY), (const bf16_t*)(p.ws + OFF_WTOUT) + (size_t)l * DM * DM, (l == 0) ? MROWS : NLAT, DM, DM};
            OrderX S; S.base.init((l == 0) ? MROWS : NLAT, DM, G, (int)blockIdx.x); S.nextra = 0; S.epm0 = 0; S.epn0 = 0; S.epnn = 1;
            EpiOut E{(l == 0) ? p.x : p.out, p.ctx, p.out, (float*)(p.ws + OFF_ZC), (const float*)(p.ws + OFF_MODF) + (size_t)l * 5 * 6144 + 4096,
                     (l == 0) ? (const float*)nullptr : (const float*)(p.ws + OFF_O1), p.ln_g, p.ln_b};
            pg8::gemm_phase<EpiOut, OrderX, true, true>(lds, g, S, E);
        }
        GSYNC();
        if constexpr (PH_MASK & 32) {
            if (l == 1) phase_ln(p, 1, true, 0, NLAT, (int)blockIdx.x, G);
            else if (G == 256) {
                phase_ln(p, 0, false, NLAT, MROWS, (int)blockIdx.x, G);
                GSYNC();
                if (blockIdx.x < 32) {
                    pg8::Gemm g{(const bf16_t*)(p.ws + OFF_HY), (const bf16_t*)(p.ws + OFF_WTIN) + (size_t)DIN * DM, NLAT, DIN, DM};
                    OrderX S; S.base.init(NLAT, DIN, G, (int)blockIdx.x); S.base.nwg = 0; S.nextra = 32; S.epm0 = 64; S.epn0 = 12; S.epnn = 8;
                    EpiIn E{(bf16_t*)(p.ws + OFF_P), (const float*)(p.ws + OFF_ROPE)};
                    pg8::gemm_phase<EpiIn, OrderX, true, true>(lds, g, S, E);
                } else phase_ln(p, 0, false, 0, NLAT, (int)blockIdx.x - 32, G - 32);
            } else phase_ln(p, 0, false, 0, MROWS, (int)blockIdx.x, G);
        }
        if (l == 0) GSYNC();
    }
}

extern "C" void kernel_launch(void* const* d_in, const int* in_sizes, int n_in, void* d_out, int out_size, void* d_ws, size_t ws_size, hipStream_t stream) {
    static int grid_blocks = 0;
    if (grid_blocks == 0) {
        if (n_in != 18 || in_sizes[0] != NLAT * DM || out_size != NLAT * DM || ws_size < WS_END) {
            fprintf(stderr, "kernel_launch: shape/workspace mismatch: n_in %d in0 %d out %d ws %zu (need %zu)\n", n_in, n_in > 0 ? in_sizes[0] : -1, out_size, ws_size, (size_t)WS_END); grid_blocks = -1; return; }
        int dev = 0, cus = 0, per_cu = 0;
        hipGetDevice(&dev); hipDeviceGetAttribute(&cus, hipDeviceAttributeMultiprocessorCount, dev);
        if (hipFuncSetAttribute((const void*)hybrid_fwd, hipFuncAttributeMaxDynamicSharedMemorySize, LDS_BYTES) != hipSuccess) { fprintf(stderr, "kernel_launch: hipFuncSetAttribute failed\n"); grid_blocks = -1; return; }
        if (hipOccupancyMaxActiveBlocksPerMultiprocessor(&per_cu, (const void*)hybrid_fwd, NTHREADS, LDS_BYTES) != hipSuccess || per_cu < 1) { fprintf(stderr, "kernel_launch: occupancy query gave %d\n", per_cu); per_cu = 1; }
        (void)hipGetLastError();
        grid_blocks = cus * 1;
        if (grid_blocks > 256) grid_blocks = 256;
    }
    if (grid_blocks < 0) return;
    Params p{};
    p.x = (const float*)d_in[0]; p.c = (const float*)d_in[1]; p.ctx = (const float*)d_in[2]; p.c_ctx = (const float*)d_in[3]; p.w_mod = (const float*)d_in[4]; p.b_mod = (const float*)d_in[5];
    p.w_in = (const float*)d_in[6]; p.conv_w = (const float*)d_in[7]; p.lq1 = (const float*)d_in[8]; p.lk1 = (const float*)d_in[9]; p.lq2 = (const float*)d_in[10]; p.lk2 = (const float*)d_in[11];
    p.subln_g = (const float*)d_in[12]; p.pool_w = (const float*)d_in[13]; p.pool_scale = (const float*)d_in[14]; p.w_out = (const float*)d_in[15]; p.ln_g = (const float*)d_in[16]; p.ln_b = (const float*)d_in[17];
    p.out = (float*)d_out; p.ws = (unsigned char*)d_ws;
    if (hipMemsetAsync(d_ws, 0, 16384, stream) != hipSuccess) { fprintf(stderr, "kernel_launch: hipMemsetAsync failed\n"); return; }
    void* args[] = {&p};
    const hipError_t e = hipLaunchCooperativeKernel((const void*)hybrid_fwd, dim3(grid_blocks), dim3(NTHREADS), args, LDS_BYTES, stream);
    if (e != hipSuccess) fprintf(stderr, "kernel_launch: cooperative launch failed: %s (grid %d)\n", hipGetErrorString(e), grid_blocks);
}
```
